# Optimizing an MI355X kernel written in HIP

```python
import math
import jax, jax.numpy as jnp
from jax import lax
import numpy as np

D_MODEL = 1024
BATCH = 16
SEQ = 2048
DEPTH = 4
DEC_BATCH = 4
DEC_SEQ = 4096
PAST_LEN = 128

N_META = 16
D_MIX = D_MODEL
HEAD_DIM = 64
N_Q_HEADS = 8
N_KV_HEADS = 2
Q_PER_KV = N_Q_HEADS // N_KV_HEADS
D_ATTN = N_Q_HEADS * HEAD_DIM
D_KV = N_KV_HEADS * HEAD_DIM
WINDOW = 128
BLOCK = 128
D_FOURIER = D_MIX // 4
FOURIER_GROUP = 64
N_FOURIER_GROUPS = D_FOURIER // FOURIER_GROUP
D_CONV = D_MIX - D_ATTN - D_FOURIER
CONV_WIDTH = 31
D_IN = D_ATTN + 2 * D_KV + D_FOURIER + 2 * D_CONV
D_FF = ((8 * D_MODEL // 3 + 127) // 128) * 128
EPS = 1e-6
NEG = -1e30

kernel_name = "hymba_style_fnet_conformer_encoder"


def rms_norm(x, g):
    xf = x.astype(jnp.float32)
    y = xf * lax.rsqrt(jnp.mean(xf * xf, axis=-1, keepdims=True) + EPS)
    return (y * g.astype(jnp.float32)).astype(x.dtype)


def swiglu(x, w_gate, w_up, w_down):
    return (jax.nn.silu(x @ w_gate) * (x @ w_up)) @ w_down


def alibi_slopes():
    i = jnp.arange(1, N_Q_HEADS + 1, dtype=jnp.float32)
    return jnp.exp2(-8.0 * i / N_Q_HEADS)


def windowed_gqa(q, k, v, sink):
    B, L = q.shape[0], q.shape[1]
    lead = BLOCK - N_META
    nb = (L - N_META) // BLOCK + 1
    scale = 1.0 / math.sqrt(HEAD_DIM)
    qb = jnp.pad(q, ((0, 0), (lead, 0), (0, 0), (0, 0))).reshape(B, nb, BLOCK, N_KV_HEADS, Q_PER_KV, HEAD_DIM)

    def band(t):
        tp = jnp.pad(t, ((0, 0), (BLOCK + lead, BLOCK), (0, 0), (0, 0))).reshape(B, nb + 2, BLOCK, N_KV_HEADS, HEAD_DIM)
        return jnp.concatenate([tp[:, :-2], tp[:, 1:-1], tp[:, 2:]], axis=2)

    kb, vb = band(k), band(v)
    km, vm = k[:, :N_META], v[:, :N_META]

    qpos = (jnp.arange(nb * BLOCK) - lead).reshape(nb, BLOCK)
    kpos = jnp.arange(nb)[:, None] * BLOCK + jnp.arange(3 * BLOCK)[None, :] - BLOCK - lead
    dist = jnp.abs(qpos[:, :, None] - kpos[:, None, :])
    kvalid = (kpos >= N_META) & (kpos < L)
    valid = (dist <= WINDOW) & kvalid[:, None, :]
    slopes = alibi_slopes()
    bias = jnp.where(valid[:, None], -slopes[None, :, None, None] * dist[:, None].astype(jnp.float32), NEG)
    bias = bias.reshape(nb, N_KV_HEADS, Q_PER_KV, BLOCK, 3 * BLOCK)

    s_band = jnp.einsum('bnqhgd,bnkhd->bnhgqk', qb, kb).astype(jnp.float32) * scale + bias
    s_meta = jnp.einsum('bnqhgd,bmhd->bnhgqm', qb, km).astype(jnp.float32) * scale
    s_sink = jnp.broadcast_to(sink.astype(jnp.float32).reshape(1, 1, N_KV_HEADS, Q_PER_KV, 1, 1),
                              s_meta.shape[:-1] + (1,))
    p = jax.nn.softmax(jnp.concatenate([s_meta, s_band, s_sink], axis=-1), axis=-1)
    p_meta = p[..., :N_META].astype(v.dtype)
    p_band = p[..., N_META:N_META + 3 * BLOCK].astype(v.dtype)
    o = (jnp.einsum('bnhgqm,bmhd->bnqhgd', p_meta, vm)
         + jnp.einsum('bnhgqk,bnkhd->bnqhgd', p_band, vb))
    return o.reshape(B, nb * BLOCK, D_ATTN)[:, lead:]


def fourier_mix(u):
    B, L, _ = u.shape
    ug = u.reshape(B, L, N_FOURIER_GROUPS, FOURIER_GROUP).astype(jnp.float32)
    f = jnp.fft.fft2(ug, axes=(1, 3), norm="ortho").real
    return f.reshape(B, L, D_FOURIER).astype(u.dtype)


def conv_module(a, gate, w_dw, b_dw, ln_g, ln_b):
    u = a * jax.nn.sigmoid(gate)
    y = lax.conv_general_dilated(u, w_dw[:, None, :], window_strides=(1,),
                                 padding=[(CONV_WIDTH // 2, CONV_WIDTH // 2)],
                                 dimension_numbers=('NWC', 'WIO', 'NWC'),
                                 feature_group_count=D_CONV) + b_dw
    yf = y.astype(jnp.float32)
    mu = jnp.mean(yf, axis=-1, keepdims=True)
    var = jnp.mean(jnp.square(yf - mu), axis=-1, keepdims=True)
    yn = (yf - mu) * lax.rsqrt(var + EPS) * ln_g.astype(jnp.float32) + ln_b.astype(jnp.float32)
    return jax.nn.silu(yn).astype(a.dtype)


def hybrid_mixer(h, w_in, w_dw, b_dw, ln_g, ln_b, sink, g_branch, w_out):
    B, L, _ = h.shape
    z = h @ w_in
    c1 = D_ATTN
    c2 = c1 + D_KV
    c3 = c2 + D_KV
    c4 = c3 + D_FOURIER
    c5 = c4 + D_CONV
    q, k, v, uf, ua, ug = jnp.split(z, [c1, c2, c3, c4, c5], axis=-1)
    o_attn = windowed_gqa(q.reshape(B, L, N_Q_HEADS, HEAD_DIM),
                          k.reshape(B, L, N_KV_HEADS, HEAD_DIM),
                          v.reshape(B, L, N_KV_HEADS, HEAD_DIM), sink)
    o_four = fourier_mix(uf)
    o_conv = conv_module(ua, ug, w_dw, b_dw, ln_g, ln_b)
    o = jnp.concatenate([
        rms_norm(o_attn, g_branch[:D_ATTN]),
        rms_norm(o_four, g_branch[D_ATTN:D_ATTN + D_FOURIER]),
        rms_norm(o_conv, g_branch[D_ATTN + D_FOURIER:]),
    ], axis=-1)
    return o @ w_out


def encoder_trunk(x, meta_tokens, ffn1_norm, ffn1_w_gate, ffn1_w_up, ffn1_w_down,
                  mix_norm, w_in, conv_w_dw, conv_b_dw, conv_ln_g, conv_ln_b, attn_sink,
                  branch_norm, w_out, ffn2_norm, ffn2_w_gate, ffn2_w_up, ffn2_w_down, final_norm):
    B = x.shape[0]
    meta = jnp.broadcast_to(meta_tokens.astype(x.dtype)[None], (B, N_META, D_MODEL))
    h = jnp.concatenate([meta, x], axis=1)
    for l in range(DEPTH):
        h = h + 0.5 * swiglu(rms_norm(h, ffn1_norm[l]), ffn1_w_gate[l], ffn1_w_up[l], ffn1_w_down[l])
        h = h + hybrid_mixer(rms_norm(h, mix_norm[l]), w_in[l], conv_w_dw[l], conv_b_dw[l],
                             conv_ln_g[l], conv_ln_b[l], attn_sink[l], branch_norm[l], w_out[l])
        h = h + 0.5 * swiglu(rms_norm(h, ffn2_norm[l]), ffn2_w_gate[l], ffn2_w_up[l], ffn2_w_down[l])
    return rms_norm(h, final_norm)[:, N_META:]


def setup_inputs(seed: int = 0) -> dict:
    key = jax.random.key(seed)
    ks = jax.random.split(key, 24)
    f32 = jnp.float32

    def nrm(k, shape, scale):
        return jax.random.normal(k, shape, f32) * scale

    def gain(k, shape):
        return 1.0 + 0.02 * jax.random.normal(k, shape, f32)

    return {
        "x_prompt": nrm(ks[0], (BATCH, SEQ, D_MODEL), 1.0),
        "x_sample": nrm(ks[1], (DEC_BATCH, DEC_SEQ, D_MODEL), 1.0),
        "meta_tokens": nrm(ks[2], (N_META, D_MODEL), 1.0),
        "ffn1_norm": gain(ks[3], (DEPTH, D_MODEL)),
        "ffn1_w_gate": nrm(ks[4], (DEPTH, D_MODEL, D_FF), D_MODEL ** -0.5),
        "ffn1_w_up": nrm(ks[5], (DEPTH, D_MODEL, D_FF), D_MODEL ** -0.5),
        "ffn1_w_down": nrm(ks[6], (DEPTH, D_FF, D_MODEL), D_FF ** -0.5),
        "mix_norm": gain(ks[7], (DEPTH, D_MODEL)),
        "w_in": nrm(ks[8], (DEPTH, D_MODEL, D_IN), D_MODEL ** -0.5),
        "conv_w_dw": nrm(ks[9], (DEPTH, CONV_WIDTH, D_CONV), CONV_WIDTH ** -0.5),
        "conv_b_dw": nrm(ks[10], (DEPTH, D_CONV), 0.01),
        "conv_ln_g": gain(ks[11], (DEPTH, D_CONV)),
        "conv_ln_b": nrm(ks[12], (DEPTH, D_CONV), 0.01),
        "attn_sink": nrm(ks[13], (DEPTH, N_Q_HEADS), 0.5),
        "branch_norm": gain(ks[14], (DEPTH, D_MIX)),
        "w_out": nrm(ks[15], (DEPTH, D_MIX, D_MODEL), D_MIX ** -0.5),
        "ffn2_norm": gain(ks[16], (DEPTH, D_MODEL)),
        "ffn2_w_gate": nrm(ks[17], (DEPTH, D_MODEL, D_FF), D_MODEL ** -0.5),
        "ffn2_w_up": nrm(ks[18], (DEPTH, D_MODEL, D_FF), D_MODEL ** -0.5),
        "ffn2_w_down": nrm(ks[19], (DEPTH, D_FF, D_MODEL), D_FF ** -0.5),
        "final_norm": gain(ks[20], (D_MODEL,)),
    }


def reference(x_prompt, x_sample, meta_tokens, ffn1_norm, ffn1_w_gate, ffn1_w_up, ffn1_w_down,
              mix_norm, w_in, conv_w_dw, conv_b_dw, conv_ln_g, conv_ln_b, attn_sink,
              branch_norm, w_out, ffn2_norm, ffn2_w_gate, ffn2_w_up, ffn2_w_down, final_norm):
    y_prompt = encoder_trunk(x_prompt, meta_tokens, ffn1_norm, ffn1_w_gate, ffn1_w_up, ffn1_w_down,
                             mix_norm, w_in, conv_w_dw, conv_b_dw, conv_ln_g, conv_ln_b, attn_sink,
                             branch_norm, w_out, ffn2_norm, ffn2_w_gate, ffn2_w_up, ffn2_w_down, final_norm)
    y_sample = encoder_trunk(x_sample, meta_tokens, ffn1_norm, ffn1_w_gate, ffn1_w_up, ffn1_w_down,
                             mix_norm, w_in, conv_w_dw, conv_b_dw, conv_ln_g, conv_ln_b, attn_sink,
                             branch_norm, w_out, ffn2_norm, ffn2_w_gate, ffn2_w_up, ffn2_w_down, final_norm)
    return (y_prompt, y_sample)
```

```cpp
#include <hip/hip_runtime.h>
#include <hip/hip_cooperative_groups.h>
#include <cstdint>
#include <cstdio>
namespace cg = cooperative_groups;

#define LAS __attribute__((address_space(3)))
typedef unsigned short bf16_t;
typedef short bf16x8 __attribute__((ext_vector_type(8)));
typedef short s16x4 __attribute__((ext_vector_type(4)));
typedef float f32x4 __attribute__((ext_vector_type(4)));
typedef unsigned u32x4 __attribute__((ext_vector_type(4)));
typedef unsigned u32x2 __attribute__((ext_vector_type(2)));

constexpr int D = 1024, DFF = 2816, DEPTH = 4;
constexpr int LP = 2064, LS = 4112, NBP = 16, NBS = 4, NMETA = 16, SEQP = 2048, SEQS = 4096;
constexpr int TP = NBP * LP;
constexpr int TS = NBS * LS;
constexpr int T = TP + TS;
constexpr int MP = 49664;
constexpr int DZ = 1280;
constexpr int DIN = 1536;
constexpr int KP_P = 4224, KP_S = 8320;
constexpr int MT_P = 2304, MT_S = 4352;
constexpr int LDB_P = 2 * LP, LDB_S = 2 * LS;
constexpr float EPS = 1e-6f;

constexpr size_t WS_H = 0;
constexpr size_t WS_ACT = WS_H + (size_t)MP * D * 4;
constexpr size_t WS_Z = WS_ACT;
constexpr size_t WS_O = WS_Z + (size_t)MP * DZ * 2;
constexpr size_t WS_PQ = WS_O + (size_t)MP * D * 2;
constexpr size_t WS_PQ_S = WS_PQ + (size_t)NBP * 256 * LDB_P * 2;
constexpr size_t WS_PQ_END = WS_PQ_S + (size_t)NBS * 256 * LDB_S * 2;
constexpr size_t WS_TAIL = WS_ACT + (size_t)MP * DFF * 2;
static_assert(WS_PQ_END <= WS_TAIL, "PQ overlay");
constexpr size_t WS_GUARD = WS_TAIL;
constexpr size_t WS_SS = WS_GUARD + 4096;
constexpr size_t WS_WG1 = WS_SS + (size_t)13 * MP * 8;
constexpr size_t WS_WD1 = WS_WG1 + (size_t)2 * DFF * D * 2;
constexpr size_t WS_WIN = WS_WD1 + (size_t)D * DFF * 2;
constexpr size_t WS_WPQ = WS_WIN + (size_t)DZ * D * 2;
constexpr size_t WS_WOUT = WS_WPQ + (size_t)512 * D * 2;
constexpr size_t WS_WG2 = WS_WOUT + (size_t)D * D * 2;
constexpr size_t WS_WD2 = WS_WG2 + (size_t)2 * DFF * D * 2;
constexpr size_t WS_END = WS_WD2 + (size_t)D * DFF * 2;
static_assert(WS_END <= (size_t)512 * 1024 * 1024, "workspace");
constexpr size_t DO_HB = 0;
constexpr size_t DO_TABP = DO_HB + (size_t)MP * D * 2;
constexpr size_t DO_TABS = DO_TABP + (size_t)MT_P * KP_P * 2;
constexpr size_t DO_END = DO_TABS + (size_t)MT_S * KP_S * 2;
static_assert(DO_END <= (size_t)(NBP * SEQP + NBS * SEQS) * D * 4, "d_out scratch");

constexpr int LDS_BYTES = 147456;
constexpr int NWAVES = 8;

__device__ __forceinline__ unsigned cvt_pk_bf16(float lo, float hi) { unsigned r; asm volatile("v_cvt_pk_bf16_f32 %0, %1, %2" : "=v"(r) : "v"(lo), "v"(hi)); return r; }
__device__ __forceinline__ unsigned f2bf(float f) { unsigned u = __builtin_bit_cast(unsigned, f); return (u + 0x7fffu + ((u >> 16) & 1u)) >> 16; }
__device__ __forceinline__ unsigned pk2(float lo, float hi) { return f2bf(lo) | (f2bf(hi) << 16); }
__device__ __forceinline__ float bf_lo(unsigned w) { return __builtin_bit_cast(float, w << 16); }
__device__ __forceinline__ float bf_hi(unsigned w) { return __builtin_bit_cast(float, w & 0xffff0000u); }
__device__ __forceinline__ float wave_sum(float v) {
#pragma unroll
    for (int o = 1; o < 64; o <<= 1) v += __shfl_xor(v, o);
    return v;
}
typedef unsigned long long u64;
typedef u64 u64x2 __attribute__((ext_vector_type(2)));
__device__ __forceinline__ float rs1024f(float ss) { return __builtin_amdgcn_rsqf(ss * (1.0f / 1024.0f) + EPS); }
__device__ __forceinline__ float rs1024(u64 ss) { return __builtin_amdgcn_rsqf((float)ss * (1.0f / (16777216.0f * 1024.0f)) + EPS); }
__device__ __forceinline__ u64 ss_fix(float q) { return (u64)(q * 16777216.0f); }
#define LDS_WAIT() asm volatile("s_waitcnt lgkmcnt(0)" ::: "memory")

namespace pg8 {
constexpr int BM = 256, BK = 64, HALF = 128, HTB = HALF * BK * 2, STAGE_BYTES = 8 * HTB, NXCD = 8, WGM = 8;
__host__ __device__ __forceinline__ int lds_byte(int r, int c) { const int st = (r >> 4) * 2 + (c >> 5), rr = r & 15, cc = c & 31, ob = rr * 64 + cc * 2; return st * 1024 + (ob ^ (((ob >> 9) & 1) << 5)); }
__host__ __device__ __forceinline__ void stage_rc(int b, int& R, int& C) { const int st = b / 1024, sb = b % 1024, swz = sb ^ (((sb >> 9) & 1) << 5); R = (st >> 1) * 16 + swz / 64; C = (st & 1) * 32 + (swz % 64) / 2; }
__host__ __device__ __forceinline__ int perm32(int rho) { const int n = rho >> 4, i = rho & 15; return 8 * (i >> 2) + 4 * n + (i & 3); }

struct Unit { int pm, pn; };
struct Gemm { const bf16_t* A; const bf16_t* Bt; int lda, ldb, K; };

struct StaticOrder {
    int nM, nN, nwg, G, c;
    __device__ void init(int M, int N, int G_, int c_) { nM = M / BM; nN = N / BM; nwg = nM * nN; G = G_; c = c_; }
    __device__ bool next(int i, Unit& u) const {
        const long L = (long)i * G + c; if (L >= nwg) return false;
        int wgid = (int)L; { const int q = nwg / NXCD, r = nwg % NXCD, xcd = wgid % NXCD, off = wgid / NXCD; wgid = (xcd < r ? xcd * (q + 1) : r * (q + 1) + (xcd - r) * q) + off; }
        const int nig = WGM * nN, gid = wgid / nig, fm = gid * WGM, gsz = (nM - fm) < WGM ? (nM - fm) : WGM;
        u.pm = fm + ((wgid % nig) % gsz); u.pn = (wgid % nig) / gsz; return true;
    }
};

template <class Epi, bool ALIGN_EPI>
__device__ __forceinline__ void gemm_phase(LAS unsigned char* lds, const Gemm g, const StaticOrder& S, const Epi& E) {
    int tid_ = threadIdx.x; asm volatile("" : "+v"(tid_));
    const int tid = tid_, wid = __builtin_amdgcn_readfirstlane(tid >> 6), lane = tid & 63, wr = wid >> 2, wc = wid & 3, fr = lane & 15, fq = lane >> 4;
    const int nt = g.K / BK;
    unsigned voffA[2], voffB[2];
#pragma unroll
    for (int i = 0; i < 2; ++i) { int R, C; stage_rc(tid * 16 + i * 8192, R, C); const int Rb = Epi::PERM ? ((R & ~31) + perm32(R & 31)) : R;
        voffA[i] = (unsigned)(R * g.lda + C) * 2u; voffB[i] = (unsigned)(Rb * g.ldb + C) * 2u; }
    const size_t kstep = (size_t)(BK * 2);
    const size_t hstepA = (size_t)HALF * g.lda * 2, hstepB = (size_t)HALF * g.ldb * 2;
    const size_t tstepA = 2 * hstepA, tstepB = 2 * hstepB;
    const unsigned ldsw = (unsigned)wid * 1024u;
    const int aoff = lds_byte(wr * 64 + fr, fq * 8), boff = lds_byte(wc * 32 + fr, fq * 8);
#define PG8_SA(b, h) (((b) * 2 + (h)) * HTB)
#define PG8_SB(b, h) ((4 + (b) * 2 + (h)) * HTB)
#define PG8_STAGE(bufoff, gbase, voff) do { _Pragma("unroll") for (int _i = 0; _i < 2; ++_i) \
        __builtin_amdgcn_global_load_lds((const unsigned*)((const char*)(gbase) + (voff)[_i]), (LAS unsigned*)(lds + (bufoff) + ldsw + _i * 8192), 16, 0, 0); } while (0)
#define PG8_LDA(dst, b, h) do { _Pragma("unroll") for (int m = 0; m < 4; ++m) _Pragma("unroll") for (int k = 0; k < 2; ++k) dst[m][k] = *(const LAS bf16x8*)(lds + PG8_SA(b, h) + aoff + m * 2048 + k * 1024); } while (0)
#define PG8_LDB(dst, b, h) do { _Pragma("unroll") for (int n = 0; n < 2; ++n) _Pragma("unroll") for (int k = 0; k < 2; ++k) dst[n][k] = *(const LAS bf16x8*)(lds + PG8_SB(b, h) + boff + n * 2048 + k * 1024); } while (0)
#define PG8_MMA(ai, bj, At, Bt) do { __builtin_amdgcn_s_setprio(1); _Pragma("unroll") for (int m = 0; m < 4; ++m) _Pragma("unroll") for (int n = 0; n < 2; ++n) _Pragma("unroll") for (int k = 0; k < 2; ++k) \
        acc[ai][bj][m][n] = __builtin_amdgcn_mfma_f32_16x16x32_bf16(Bt[n][k], At[m][k], acc[ai][bj][m][n], 0, 0, 0); __builtin_amdgcn_s_setprio(0); } while (0)
#define PG8_WAIT_V(n) asm volatile("s_waitcnt vmcnt(" #n ")" ::: "memory")
#define PG8_WAIT_L(n) asm volatile("s_waitcnt lgkmcnt(" #n ")" ::: "memory")
#define PG8_BAR __builtin_amdgcn_s_barrier()
#define PG8_SCHED __builtin_amdgcn_sched_barrier(0)
    Unit cur, nxt; int ui = 0;
    if (!S.next(0, cur)) return;
    f32x4 acc[2][2][4][2];
#pragma unroll
    for (int a = 0; a < 2; ++a)
#pragma unroll
        for (int b = 0; b < 2; ++b)
#pragma unroll
            for (int m = 0; m < 4; ++m)
#pragma unroll
                for (int n = 0; n < 2; ++n) acc[a][b][m][n] = (f32x4){0.f, 0.f, 0.f, 0.f};
    bf16x8 At[4][2], B0[2][2], B1[2][2];
    const char* cA = (const char*)g.A + (size_t)cur.pm * tstepA; const char* cB = (const char*)g.Bt + (size_t)cur.pn * tstepB;
    PG8_STAGE(PG8_SB(0, 0), cB, voffB); PG8_STAGE(PG8_SB(0, 1), cB + hstepB, voffB); PG8_STAGE(PG8_SA(0, 0), cA, voffA); PG8_STAGE(PG8_SA(0, 1), cA + hstepA, voffA);
    if (wr == 1) PG8_BAR;
    PG8_WAIT_V(2); PG8_BAR;
    PG8_STAGE(PG8_SB(1, 0), cB + kstep, voffB); PG8_STAGE(PG8_SA(1, 0), cA + kstep, voffA); PG8_STAGE(PG8_SB(1, 1), cB + hstepB + kstep, voffB);
    PG8_WAIT_V(6); PG8_BAR;
    for (;;) {
        const bool has_next = S.next(ui + 1, nxt);
        const char* nA = has_next ? (const char*)g.A + (size_t)nxt.pm * tstepA : cA; const char* nB = has_next ? (const char*)g.Bt + (size_t)nxt.pn * tstepB : cB;
        for (int t = 0; t < nt; t += 2) {
            const bool last = (t == nt - 2);
            const char* a1 = cA + (size_t)(t + 1) * kstep;
            const char* a2 = last ? nA : cA + (size_t)(t + 2) * kstep; const char* b2 = last ? nB : cB + (size_t)(t + 2) * kstep;
            const char* a3 = a2 + kstep; const char* b3 = b2 + kstep;
            PG8_LDB(B0, 0, 0); PG8_LDB(B1, 0, 1); PG8_SCHED; PG8_LDA(At, 0, 0); PG8_STAGE(PG8_SA(1, 1), a1 + hstepA, voffA);
            PG8_WAIT_V(8); PG8_WAIT_L(0); PG8_BAR; PG8_MMA(0, 0, At, B0); PG8_MMA(0, 1, At, B1); PG8_BAR; PG8_SCHED;
            PG8_LDA(At, 0, 1); PG8_STAGE(PG8_SB(0, 0), b2, voffB); PG8_STAGE(PG8_SB(0, 1), b2 + hstepB, voffB); PG8_STAGE(PG8_SA(0, 0), a2, voffA);
            PG8_WAIT_V(8); PG8_WAIT_L(0); PG8_BAR; PG8_MMA(1, 0, At, B0); PG8_MMA(1, 1, At, B1); PG8_BAR; PG8_SCHED;
            PG8_LDB(B0, 1, 0); PG8_LDB(B1, 1, 1); PG8_SCHED; PG8_LDA(At, 1, 0); PG8_STAGE(PG8_SA(0, 1), a2 + hstepA, voffA);
            PG8_WAIT_V(8); PG8_WAIT_L(0); PG8_BAR; PG8_MMA(0, 0, At, B0); PG8_MMA(0, 1, At, B1); PG8_BAR; PG8_SCHED;
            PG8_LDA(At, 1, 1); PG8_STAGE(PG8_SB(1, 0), b3, voffB); PG8_STAGE(PG8_SB(1, 1), b3 + hstepB, voffB); PG8_STAGE(PG8_SA(1, 0), a3, voffA);
            PG8_WAIT_V(8); PG8_WAIT_L(0); PG8_BAR; PG8_MMA(1, 0, At, B0); PG8_MMA(1, 1, At, B1); PG8_BAR; PG8_SCHED;
        }
        if constexpr (ALIGN_EPI) { if (wr == 0) PG8_BAR; }
        if constexpr (!Epi::AFTER_DRAIN) { E(acc, cur, wr, wc, fr, fq); }
        if (!has_next) break;
#pragma unroll
        for (int a = 0; a < 2; ++a)
#pragma unroll
            for (int b = 0; b < 2; ++b)
#pragma unroll
                for (int m = 0; m < 4; ++m)
#pragma unroll
                    for (int n = 0; n < 2; ++n) acc[a][b][m][n] = (f32x4){0.f, 0.f, 0.f, 0.f};
        cur = nxt; cA = nA; cB = nB; ++ui;
        if constexpr (ALIGN_EPI) { if (wr == 1) PG8_BAR; }
    }
    PG8_WAIT_V(0);
    if constexpr (!ALIGN_EPI) { if (wr == 0) PG8_BAR; }
    PG8_BAR;
    if constexpr (Epi::AFTER_DRAIN) { E.fused(acc, cur, wr, wc, fr, fq, lds); }
#undef PG8_SA
#undef PG8_SB
#undef PG8_STAGE
#undef PG8_LDA
#undef PG8_LDB
#undef PG8_MMA
#undef PG8_WAIT_V
#undef PG8_WAIT_L
#undef PG8_BAR
#undef PG8_SCHED
}
}

__device__ __forceinline__ float silu_mul(float g, float u) { return g * u * __builtin_amdgcn_rcpf(1.0f + __expf(-g)); }

struct EpiSwiGLU {
    static constexpr bool PERM = true, AFTER_DRAIN = false;
    bf16_t* act; const u64* ss;
    __device__ __forceinline__ void operator()(const f32x4 (&acc)[2][2][4][2], const pg8::Unit& u, int wr, int wc, int fr, int fq) const {
        const int row0 = u.pm * 256 + wr * 64 + fr, col0 = u.pn * 128 + wc * 32 + 8 * fq;
#pragma unroll
        for (int ai = 0; ai < 2; ++ai)
#pragma unroll
            for (int m = 0; m < 4; ++m) {
                const int row = row0 + ai * 128 + m * 16; const float r = rs1024(ss[row]);
                const f32x4 g0 = acc[ai][0][m][0] * r, g1 = acc[ai][0][m][1] * r, u0 = acc[ai][1][m][0] * r, u1 = acc[ai][1][m][1] * r;
                u32x4 w;
                w.x = cvt_pk_bf16(silu_mul(g0[0], u0[0]), silu_mul(g0[1], u0[1])); w.y = cvt_pk_bf16(silu_mul(g0[2], u0[2]), silu_mul(g0[3], u0[3]));
                w.z = cvt_pk_bf16(silu_mul(g1[0], u1[0]), silu_mul(g1[1], u1[1])); w.w = cvt_pk_bf16(silu_mul(g1[2], u1[2]), silu_mul(g1[3], u1[3]));
                *(u32x4*)(act + (size_t)row * DFF + col0) = w;
            }
    }
};
struct EpiDown {
    static constexpr bool PERM = true, AFTER_DRAIN = false;
    float* H; bf16_t* HB; u64* ssn; float alpha;
    __device__ __forceinline__ void operator()(const f32x4 (&acc)[2][2][4][2], const pg8::Unit& u, int wr, int wc, int fr, int fq) const {
        const int row0 = u.pm * 256 + wr * 64 + fr, col0 = u.pn * 256 + wc * 32 + 8 * fq;
#pragma unroll
        for (int ai = 0; ai < 2; ++ai)
#pragma unroll
            for (int m = 0; m < 4; ++m) {
                const int row = row0 + ai * 128 + m * 16; float* hp = H + (size_t)row * D + col0; bf16_t* bp = HB + (size_t)row * D + col0;
                float q = 0.f;
#pragma unroll
                for (int bj = 0; bj < 2; ++bj) {
                    f32x4 a0 = *(const f32x4*)(hp + bj * 128), a1 = *(const f32x4*)(hp + bj * 128 + 4);
                    a0 = a0 + acc[ai][bj][m][0] * alpha; a1 = a1 + acc[ai][bj][m][1] * alpha;
                    *(f32x4*)(hp + bj * 128) = a0; *(f32x4*)(hp + bj * 128 + 4) = a1;
                    q += (a0[0] * a0[0] + a0[1] * a0[1]) + (a0[2] * a0[2] + a0[3] * a0[3]) + (a1[0] * a1[0] + a1[1] * a1[1]) + (a1[2] * a1[2] + a1[3] * a1[3]);
                    u32x4 w; w.x = cvt_pk_bf16(a0[0], a0[1]); w.y = cvt_pk_bf16(a0[2], a0[3]); w.z = cvt_pk_bf16(a1[0], a1[1]); w.w = cvt_pk_bf16(a1[2], a1[3]);
                    *(u32x4*)(bp + bj * 128) = w;
                }
                q += __shfl_xor(q, 16); q += __shfl_xor(q, 32);
                if (fq == 0) atomicAdd(ssn + row, ss_fix(q));
                asm volatile("" ::: "memory");
            }
    }
};
struct EpiZ {
    static constexpr bool PERM = true, AFTER_DRAIN = false;
    bf16_t* Z; const u64* ss;
    __device__ __forceinline__ void operator()(const f32x4 (&acc)[2][2][4][2], const pg8::Unit& u, int wr, int wc, int fr, int fq) const {
        const int row0 = u.pm * 256 + wr * 64 + fr, col0 = u.pn * 256 + wc * 32 + 8 * fq;
#pragma unroll
        for (int ai = 0; ai < 2; ++ai)
#pragma unroll
            for (int m = 0; m < 4; ++m) {
                const int row = row0 + ai * 128 + m * 16; const float r = rs1024(ss[row]); bf16_t* zp = Z + (size_t)row * DZ + col0;
#pragma unroll
                for (int bj = 0; bj < 2; ++bj) {
                    const f32x4 a0 = acc[ai][bj][m][0] * r, a1 = acc[ai][bj][m][1] * r;
                    u32x4 w; w.x = cvt_pk_bf16(a0[0], a0[1]); w.y = cvt_pk_bf16(a0[2], a0[3]); w.z = cvt_pk_bf16(a1[0], a1[1]); w.w = cvt_pk_bf16(a1[2], a1[3]);
                    *(u32x4*)(zp + bj * 128) = w;
                }
            }
    }
};
struct EpiPQ {
    static constexpr bool PERM = true, AFTER_DRAIN = false;
    bf16_t* PQP; bf16_t* PQS; const u64* ss;
    __device__ __forceinline__ void operator()(const f32x4 (&acc)[2][2][4][2], const pg8::Unit& u, int wr, int wc, int fr, int fq) const {
        const int ch0 = wr * 64 + fr;
#pragma unroll
        for (int bj = 0; bj < 2; ++bj) {
            const int tok = u.pn * 256 + bj * 128 + wc * 32 + 8 * fq;
            if (tok < T) {
                bf16_t* base; int L2;
                if (tok < TP) { const int b = tok / LP, s = tok - b * LP; base = PQP + (size_t)b * 256 * LDB_P + u.pm * LP + s; L2 = LDB_P; }
                else { const int tt = tok - TP, b = tt / LS, s = tt - b * LS; base = PQS + (size_t)b * 256 * LDB_S + u.pm * LS + s; L2 = LDB_S; }
                f32x4 r0, r1;
#pragma unroll
                for (int j = 0; j < 2; ++j) { const u64x2 sa = *(const u64x2*)(ss + tok + 2 * j), sb2 = *(const u64x2*)(ss + tok + 4 + 2 * j);
                    r0[2 * j] = rs1024(sa[0]); r0[2 * j + 1] = rs1024(sa[1]); r1[2 * j] = rs1024(sb2[0]); r1[2 * j + 1] = rs1024(sb2[1]); }
#pragma unroll
                for (int ai = 0; ai < 2; ++ai)
#pragma unroll
                    for (int m = 0; m < 4; ++m) {
                        const int c = ch0 + ai * 128 + m * 16;
                        const f32x4 a0 = acc[ai][bj][m][0] * r0, a1 = acc[ai][bj][m][1] * r1;
                        u32x4 w; w.x = cvt_pk_bf16(a0[0], a0[1]); w.y = cvt_pk_bf16(a0[2], a0[3]); w.z = cvt_pk_bf16(a1[0], a1[1]); w.w = cvt_pk_bf16(a1[2], a1[3]);
                        *(u32x4*)(base + (size_t)c * L2) = w;
                    }
            }
        }
    }
};
struct EpiDFT {
    static constexpr bool PERM = true, AFTER_DRAIN = true;
    bf16_t* O; int L, rowoff;
    __device__ __forceinline__ void operator()(const f32x4 (&)[2][2][4][2], const pg8::Unit&, int, int, int, int) const {}
    __device__ __forceinline__ void fused(const f32x4 (&acc)[2][2][4][2], const pg8::Unit& u, int wr, int wc, int fr, int fq, LAS unsigned char* lds) const {
        LAS float* P = (LAS float*)lds;
#pragma unroll
        for (int ai = 0; ai < 2; ++ai)
#pragma unroll
            for (int m = 0; m < 4; ++m) {
                float q = 0.f;
#pragma unroll
                for (int bj = 0; bj < 2; ++bj)
#pragma unroll
                    for (int n = 0; n < 2; ++n) { const f32x4 x = acc[ai][bj][m][n]; q += (x[0] * x[0] + x[1] * x[1]) + (x[2] * x[2] + x[3] * x[3]); }
                q += __shfl_xor(q, 16); q += __shfl_xor(q, 32);
                if (fq == 0) P[(ai * 128 + wr * 64 + m * 16 + fr) * 4 + wc] = q;
            }
        LDS_WAIT(); __builtin_amdgcn_s_barrier(); asm volatile("" ::: "memory");
#pragma unroll
        for (int ai = 0; ai < 2; ++ai)
#pragma unroll
            for (int m = 0; m < 4; ++m) {
                const int rl = ai * 128 + wr * 64 + m * 16 + fr; const f32x4 pp = *(const LAS f32x4*)(P + rl * 4);
                const float rinv = __builtin_amdgcn_rsqf(((pp[0] + pp[1]) + (pp[2] + pp[3])) * (1.0f / 256.0f) + EPS);
                const int t = u.pm * 256 + rl;
                if (t < L) {
                    bf16_t* op = O + (size_t)(rowoff + u.pn * L + t) * D + 512 + wc * 32 + 8 * fq;
#pragma unroll
                    for (int bj = 0; bj < 2; ++bj) {
                        const f32x4 a0 = acc[ai][bj][m][0] * rinv, a1 = acc[ai][bj][m][1] * rinv;
                        u32x4 w; w.x = cvt_pk_bf16(a0[0], a0[1]); w.y = cvt_pk_bf16(a0[2], a0[3]); w.z = cvt_pk_bf16(a1[0], a1[1]); w.w = cvt_pk_bf16(a1[2], a1[3]);
                        *(u32x4*)(op + bj * 128) = w;
                    }
                }
            }
        LDS_WAIT(); __builtin_amdgcn_s_barrier(); asm volatile("" ::: "memory");
    }
};

__device__ __forceinline__ void tr_item(const float* W, int ldw, int k0, int nc0, const float* gain, bf16_t* WT, int ldo, int drow0, LAS float* scr, int lane) {
#pragma unroll 8
    for (int i = 0; i < 32; ++i) { const int kk = 2 * i + (lane >> 5); const float gsc = gain ? gain[k0 + kk] : 1.0f;
        scr[kk * 33 + (lane & 31)] = W[(size_t)(k0 + kk) * ldw + nc0 + (lane & 31)] * gsc; }
    LDS_WAIT(); asm volatile("" ::: "memory");
    const int c = lane & 7;
#pragma unroll
    for (int j = 0; j < 4; ++j) { const int n = (lane >> 3) + 8 * j; const LAS float* s = scr + (8 * c) * 33 + n;
        u32x4 o; o.x = pk2(s[0 * 33], s[1 * 33]); o.y = pk2(s[2 * 33], s[3 * 33]); o.z = pk2(s[4 * 33], s[5 * 33]); o.w = pk2(s[6 * 33], s[7 * 33]);
        *(u32x4*)(WT + (size_t)(drow0 + n) * ldo + k0 + 8 * c) = o; }
    LDS_WAIT(); asm volatile("" ::: "memory");
}
__device__ __forceinline__ void wpq_item(const float* Win, const float* gain, bf16_t* WPQ, int item, LAS float* scr, int lane) {
    const int kb = item >> 4, G = (item >> 2) & 3, cq = item & 3, k0 = kb * 64;
    LAS float* tab = scr + 64 * 65;
    tab[lane] = __builtin_amdgcn_cosf((float)lane * (1.0f / 64.0f)); tab[64 + lane] = __builtin_amdgcn_sinf((float)lane * (1.0f / 64.0f));
#pragma unroll 8
    for (int i = 0; i < 64; ++i) scr[lane * 65 + i] = Win[(size_t)(k0 + i) * DIN + 768 + 64 * G + lane] * gain[k0 + i];
    LDS_WAIT(); asm volatile("" ::: "memory");
    for (int cc = 0; cc < 16; ++cc) {
        const int cp = 16 * cq + cc; float aP = 0.f, aQ = 0.f; int idx = 0;
#pragma unroll 8
        for (int c = 0; c < 64; ++c) { const float v = scr[c * 65 + lane]; aP += v * tab[idx]; aQ += v * tab[64 + idx]; idx = (idx + cp) & 63; }
        WPQ[(size_t)(64 * G + cp) * D + k0 + lane] = (bf16_t)f2bf(aP);
        WPQ[(size_t)(256 + 64 * G + cp) * D + k0 + lane] = (bf16_t)f2bf(aQ);
    }
    LDS_WAIT(); asm volatile("" ::: "memory");
}
struct WPtrs { const float *n1, *g1, *u1, *d1, *nm, *win, *nb, *wout, *n2, *g2, *u2, *d2; };
constexpr int IT_GATE = 16 * 88, IT_DOWN = 44 * 32, IT_WIN = 16 * 40, IT_WPQ = 256, IT_WOUT = 16 * 32;
constexpr int IT_SETA = 2 * IT_GATE + IT_DOWN + IT_WIN + IT_WPQ;
constexpr int IT_SETB = IT_WOUT + 2 * IT_GATE + IT_DOWN;
__device__ __forceinline__ void gate_item(const float* Wsrc, const float* gain, bf16_t* WG, int r, int upsel, LAS float* scr, int lane) {
    const int kb = r / 88, nb = r % 88, n = 32 * nb;
    tr_item(Wsrc, DFF, 64 * kb, n, gain, WG, D, 256 * (n >> 7) + (n & 127) + 128 * upsel, scr, lane);
}
__device__ __forceinline__ void wconv_setA(const WPtrs& w, unsigned char* ws, int it, LAS float* scr, int lane) {
    int r = it;
    if (r < IT_GATE) { gate_item(w.g1, w.n1, (bf16_t*)(ws + WS_WG1), r, 0, scr, lane); return; } r -= IT_GATE;
    if (r < IT_GATE) { gate_item(w.u1, w.n1, (bf16_t*)(ws + WS_WG1), r, 1, scr, lane); return; } r -= IT_GATE;
    if (r < IT_DOWN) { const int kb = r >> 5, nb = r & 31; tr_item(w.d1, D, 64 * kb, 32 * nb, nullptr, (bf16_t*)(ws + WS_WD1), DFF, 32 * nb, scr, lane); return; } r -= IT_DOWN;
    if (r < IT_WIN) { const int kb = r / 40, nb = r % 40; const int sc = nb < 24 ? 32 * nb : 1024 + 32 * (nb - 24);
        tr_item(w.win, DIN, 64 * kb, sc, w.nm, (bf16_t*)(ws + WS_WIN), D, 32 * nb, scr, lane); return; } r -= IT_WIN;
    wpq_item(w.win, w.nm, (bf16_t*)(ws + WS_WPQ), r, scr, lane);
}
__device__ __forceinline__ void wconv_setB(const WPtrs& w, unsigned char* ws, int it, LAS float* scr, int lane) {
    int r = it;
    if (r < IT_WOUT) { const int kb = r >> 5, nb = r & 31; tr_item(w.wout, D, 64 * kb, 32 * nb, w.nb, (bf16_t*)(ws + WS_WOUT), D, 32 * nb, scr, lane); return; } r -= IT_WOUT;
    if (r < IT_GATE) { gate_item(w.g2, w.n2, (bf16_t*)(ws + WS_WG2), r, 0, scr, lane); return; } r -= IT_GATE;
    if (r < IT_GATE) { gate_item(w.u2, w.n2, (bf16_t*)(ws + WS_WG2), r, 1, scr, lane); return; } r -= IT_GATE;
    { const int kb = r >> 5, nb = r & 31; tr_item(w.d2, D, 64 * kb, 32 * nb, nullptr, (bf16_t*)(ws + WS_WD2), DFF, 32 * nb, scr, lane); }
}

constexpr int AT_KS = 272, AT_VS = 144, AT_KB = 64 * AT_KS  , AT_STAGE = AT_KB + 128 * AT_VS  , AT_RED = 2 * AT_STAGE, AT_QSP = AT_RED + 2048;
static_assert(AT_QSP + 8 * 8192 <= LDS_BYTES, "attention LDS");
__device__ __forceinline__ void attn_unit(LAS unsigned char* lds, const bf16_t* Z, bf16_t* O, const float* sink_l, int b, int qt, int tid) {
    const int lane = tid & 63, h = __builtin_amdgcn_readfirstlane(tid >> 6), g = lane >> 4, lq = lane & 15, kvh = h >> 2;
    int L, row0; if (b < NBP) { L = LP; row0 = b * LP; } else { L = LS; row0 = TP + (b - NBP) * LS; }
    const int t0 = qt * 64, s0 = t0 - 128;
    const float LOG2E = 1.4426950408889634f;
    const float slope2 = exp2f(-(float)(h + 1)) * LOG2E, sink2 = sink_l[h] * LOG2E, sc2 = 0.125f * LOG2E;
    LAS unsigned char* qsp = lds + AT_QSP + h * 8192 + lane * 16;
#pragma unroll
    for (int qi = 0; qi < 4; ++qi) { int t = t0 + 16 * qi + lq; t = t < L ? t : L - 1; const bf16_t* qp = Z + (size_t)(row0 + t) * DZ + h * 64 + 8 * g;
        *(LAS bf16x8*)(qsp + (2 * qi) * 1024) = *(const bf16x8*)qp; *(LAS bf16x8*)(qsp + (2 * qi + 1) * 1024) = *(const bf16x8*)(qp + 32); }
    float mrun[4], lsum[4]; f32x4 Oa[4][4];
#pragma unroll
    for (int qi = 0; qi < 4; ++qi) { mrun[qi] = sink2; lsum[qi] = (g == 0) ? 1.0f : 0.0f;
#pragma unroll
        for (int dt = 0; dt < 4; ++dt) Oa[qi][dt] = (f32x4){0.f, 0.f, 0.f, 0.f}; }
    int jlo = (81 - t0 + 63) >> 6; if (jlo < 0) jlo = 0;
    int jhi = ((L + 128 - t0 + 63) >> 6) - 1; if (jhi > 4) jhi = 4;
    const int nch = 1 + (jhi - jlo + 1);
    const int slot_s = tid & 63, c8a = tid >> 6;
    u32x4 kreg[2], vreg[2];
#define AT_LOAD(ci) do { int sp = ((ci) == 0) ? slot_s : (s0 + 64 * (jlo + (ci) - 1) + slot_s); sp = sp < 0 ? 0 : (sp > L - 1 ? L - 1 : sp); \
        const bf16_t* rp = Z + (size_t)(row0 + sp) * DZ + 512; \
        kreg[0] = *(const u32x4*)(rp + c8a * 8); kreg[1] = *(const u32x4*)(rp + (c8a + 8) * 8); \
        vreg[0] = *(const u32x4*)(rp + 128 + c8a * 8); vreg[1] = *(const u32x4*)(rp + 128 + (c8a + 8) * 8); } while (0)
#define AT_STORE(st) do { LAS unsigned char* kb_ = lds + (st) * AT_STAGE; LAS unsigned char* vb_ = kb_ + AT_KB; \
        *(LAS u32x4*)(kb_ + slot_s * AT_KS + c8a * 16) = kreg[0]; *(LAS u32x4*)(kb_ + slot_s * AT_KS + (c8a + 8) * 16) = kreg[1]; \
        _Pragma("unroll") for (int i_ = 0; i_ < 2; ++i_) { const int dr_ = (c8a + 8 * i_) * 8; \
            _Pragma("unroll") for (int e_ = 0; e_ < 4; ++e_) { const unsigned w_ = vreg[i_][e_]; \
                *(LAS unsigned short*)(vb_ + (dr_ + 2 * e_) * AT_VS + slot_s * 2) = (unsigned short)(w_ & 0xffffu); \
                *(LAS unsigned short*)(vb_ + (dr_ + 2 * e_ + 1) * AT_VS + slot_s * 2) = (unsigned short)(w_ >> 16); } } } while (0)
    AT_LOAD(0); AT_STORE(0);
    __syncthreads();
    for (int it = 0; it < nch; ++it) {
        const bool more = (it + 1 < nch);
        if (more) AT_LOAD(it + 1);
        const LAS unsigned char* kb = lds + (it & 1) * AT_STAGE; const LAS unsigned char* vb = kb + AT_KB;
        const bool is_meta = (it == 0);
        const int sb = s0 + 64 * (jlo + it - 1);
#pragma unroll
        for (int qi = 0; qi < 4; ++qi) {
            __builtin_amdgcn_sched_barrier(0);
            f32x4 S[4];
            const bf16x8 q0f = *(const LAS bf16x8*)(qsp + (2 * qi) * 1024), q1f = *(const LAS bf16x8*)(qsp + (2 * qi + 1) * 1024);
#pragma unroll
            for (int kt = 0; kt < 4; ++kt) {
                const bf16x8 k0 = *(const LAS bf16x8*)(kb + (16 * kt + lq) * AT_KS + (kvh * 64 + 8 * g) * 2);
                const bf16x8 k1 = *(const LAS bf16x8*)(kb + (16 * kt + lq) * AT_KS + (kvh * 64 + 32 + 8 * g) * 2);
                f32x4 z = (f32x4){0.f, 0.f, 0.f, 0.f};
                z = __builtin_amdgcn_mfma_f32_16x16x32_bf16(k0, q0f, z, 0, 0, 0);
                S[kt] = __builtin_amdgcn_mfma_f32_16x16x32_bf16(k1, q1f, z, 0, 0, 0);
            }
            bf16x8 Pb[2];
            {
                const int tq = t0 + 16 * qi + lq;
                float mx = -1e30f;
#pragma unroll
                for (int kt = 0; kt < 4; ++kt)
#pragma unroll
                    for (int jj = 0; jj < 4; ++jj) {
                        const int slot = 16 * kt + 4 * g + jj; float x;
                        if (is_meta) { x = (slot < 16) ? S[kt][jj] * sc2 : -1e30f; }
                        else { const int s = sb + slot; int ad = tq - s; ad = ad < 0 ? -ad : ad; const bool valid = (ad <= 128) && (s >= NMETA) && (s < L);
                            x = valid ? (S[kt][jj] * sc2 - slope2 * (float)ad) : -1e30f; }
                        S[kt][jj] = x; mx = fmaxf(mx, x);
                    }
                mx = fmaxf(mx, __shfl_xor(mx, 16)); mx = fmaxf(mx, __shfl_xor(mx, 32));
                const float mnew = fmaxf(mrun[qi], mx), alpha = __builtin_amdgcn_exp2f(mrun[qi] - mnew); mrun[qi] = mnew;
                float ps = 0.f;
#pragma unroll
                for (int kt = 0; kt < 4; ++kt)
#pragma unroll
                    for (int jj = 0; jj < 4; ++jj) { const float p = __builtin_amdgcn_exp2f(S[kt][jj] - mnew); S[kt][jj] = p; ps += p; }
                lsum[qi] = lsum[qi] * alpha + ps;
#pragma unroll
                for (int dt = 0; dt < 4; ++dt) Oa[qi][dt] = Oa[qi][dt] * alpha;
#pragma unroll
                for (int i = 0; i < 2; ++i) {
                    u32x4 w; w.x = cvt_pk_bf16(S[2 * i][0], S[2 * i][1]); w.y = cvt_pk_bf16(S[2 * i][2], S[2 * i][3]);
                    w.z = cvt_pk_bf16(S[2 * i + 1][0], S[2 * i + 1][1]); w.w = cvt_pk_bf16(S[2 * i + 1][2], S[2 * i + 1][3]);
                    Pb[i] = __builtin_bit_cast(bf16x8, w);
                }
            }
            __builtin_amdgcn_sched_barrier(0);
#pragma unroll
            for (int i = 0; i < 2; ++i)
#pragma unroll
                for (int dt = 0; dt < 4; ++dt) {
                    const LAS unsigned char* vp = vb + (kvh * 64 + 16 * dt + lq) * AT_VS + (32 * i + 4 * g) * 2;
                    const s16x4 v0 = *(const LAS s16x4*)vp, v1 = *(const LAS s16x4*)(vp + 32);
                    const bf16x8 vf = (bf16x8){v0[0], v0[1], v0[2], v0[3], v1[0], v1[1], v1[2], v1[3]};
                    Oa[qi][dt] = __builtin_amdgcn_mfma_f32_16x16x32_bf16(vf, Pb[i], Oa[qi][dt], 0, 0, 0);
                }
        }
        if (more) AT_STORE((it + 1) & 1);
        __syncthreads();
    }
#undef AT_LOAD
#undef AT_STORE
    LAS float* red = (LAS float*)(lds + AT_RED);
#pragma unroll
    for (int qi = 0; qi < 4; ++qi) {
        float l = lsum[qi]; l += __shfl_xor(l, 16); l += __shfl_xor(l, 32);
        const float inv = 1.0f / l; float q = 0.f;
#pragma unroll
        for (int dt = 0; dt < 4; ++dt) { Oa[qi][dt] = Oa[qi][dt] * inv; const f32x4 x = Oa[qi][dt]; q += (x[0] * x[0] + x[1] * x[1]) + (x[2] * x[2] + x[3] * x[3]); }
        q += __shfl_xor(q, 16); q += __shfl_xor(q, 32);
        if (g == 0) red[h * 64 + 16 * qi + lq] = q;
    }
    __syncthreads();
#pragma unroll
    for (int qi = 0; qi < 4; ++qi) {
        float tot = 0.f;
#pragma unroll
        for (int hh = 0; hh < 8; ++hh) tot += red[hh * 64 + 16 * qi + lq];
        const float rinv = __builtin_amdgcn_rsqf(tot * (1.0f / 512.0f) + EPS);
        const int t = t0 + 16 * qi + lq;
        if (t < L) {
            bf16_t* op = O + (size_t)(row0 + t) * D + h * 64 + 4 * g;
#pragma unroll
            for (int dt = 0; dt < 4; ++dt) { const f32x4 x = Oa[qi][dt] * rinv; u32x2 w; w.x = cvt_pk_bf16(x[0], x[1]); w.y = cvt_pk_bf16(x[2], x[3]); *(u32x2*)(op + 16 * dt) = w; }
        }
    }
}

__device__ __forceinline__ void conv_unit(LAS unsigned char* lds, const bf16_t* Z, bf16_t* O, const float (&w)[31], float bias, const f32x4 lng, const f32x4 lnb, int b, int qt, int tid) {
    LAS float* U = (LAS float*)lds;
    int L, row0; if (b < NBP) { L = LP; row0 = b * LP; } else { L = LS; row0 = TP + (b - NBP) * LS; }
    const int t0 = qt * 64;
    for (int p = tid; p < 94 * 32; p += 512) {
        const int tt = p >> 5, c8 = p & 31, s = t0 - 15 + tt;
        f32x4 o0 = (f32x4){0.f, 0.f, 0.f, 0.f}, o1 = o0;
        if (s >= 0 && s < L) {
            const bf16_t* rp = Z + (size_t)(row0 + s) * DZ + 768 + c8 * 8;
            const u32x4 a = *(const u32x4*)rp, gg = *(const u32x4*)(rp + 256);
#pragma unroll
            for (int e = 0; e < 4; ++e) {
                const float a_lo = bf_lo(a[e]), a_hi = bf_hi(a[e]), g_lo = bf_lo(gg[e]), g_hi = bf_hi(gg[e]);
                const float v_lo = a_lo * __builtin_amdgcn_rcpf(1.0f + __expf(-g_lo)), v_hi = a_hi * __builtin_amdgcn_rcpf(1.0f + __expf(-g_hi));
                if (e < 2) { o0[2 * e] = v_lo; o0[2 * e + 1] = v_hi; } else { o1[2 * (e - 2)] = v_lo; o1[2 * (e - 2) + 1] = v_hi; }
            }
        }
        *(LAS f32x4*)(U + tt * 256 + c8 * 8) = o0; *(LAS f32x4*)(U + tt * 256 + c8 * 8 + 4) = o1;
    }
    __syncthreads();
    const int c = tid & 255, half = tid >> 8;
    float y[32];
#pragma unroll
    for (int grp = 0; grp < 4; ++grp) {
        const int base = 32 * half + 8 * grp; float in[38];
#pragma unroll
        for (int i = 0; i < 38; ++i) in[i] = U[(base + i) * 256 + c];
#pragma unroll
        for (int o = 0; o < 8; ++o) { float a = bias;
#pragma unroll
            for (int j = 0; j < 31; ++j) a += w[j] * in[o + j];
            y[grp * 8 + o] = a; }
    }
    __syncthreads();
#pragma unroll
    for (int i = 0; i < 32; ++i) U[(32 * half + i) * 256 + c] = y[i];
    __syncthreads();
    const int lane = tid & 63, wv = tid >> 6;
    for (int k = 0; k < 8; ++k) {
        const int tl = 8 * wv + k, s = t0 + tl;
        f32x4 v = *(const LAS f32x4*)(U + tl * 256 + 4 * lane);
        const float mu = wave_sum((v[0] + v[1]) + (v[2] + v[3])) * (1.0f / 256.0f);
        v = v - mu;
        const float var = wave_sum((v[0] * v[0] + v[1] * v[1]) + (v[2] * v[2] + v[3] * v[3])) * (1.0f / 256.0f);
        const float rstd = __builtin_amdgcn_rsqf(var + EPS);
        f32x4 yn = v * rstd * lng + lnb;
#pragma unroll
        for (int e = 0; e < 4; ++e) yn[e] = yn[e] * __builtin_amdgcn_rcpf(1.0f + __expf(-yn[e]));
        const float ssq = wave_sum((yn[0] * yn[0] + yn[1] * yn[1]) + (yn[2] * yn[2] + yn[3] * yn[3]));
        const float rinv = __builtin_amdgcn_rsqf(ssq * (1.0f / 256.0f) + EPS);
        if (s < L) { u32x2 wq; wq.x = cvt_pk_bf16(yn[0] * rinv, yn[1] * rinv); wq.y = cvt_pk_bf16(yn[2] * rinv, yn[3] * rinv);
            *(u32x2*)(O + (size_t)(row0 + s) * D + 768 + 4 * lane) = wq; }
    }
    __syncthreads();
}

struct Args { const float* in[21]; float* out; unsigned char* ws; };
constexpr int N_ATT_UNITS = NBP * 33 + NBS * 65;
__device__ __forceinline__ void unit_decode(int u, int& b, int& qt) { if (u < NBP * 33) { b = u / 33; qt = u - b * 33; } else { const int r = u - NBP * 33; b = NBP + r / 65; qt = r - (r / 65) * 65; } }

typedef const __attribute__((address_space(4))) Args* ArgsP;
#define PHASE_BEGIN \
    ArgsP ap = ap0; asm volatile("" : "+s"(ap)); \
    int tid = threadIdx.x; asm volatile("" : "+v"(tid)); \
    const int lane = tid & 63, wave = __builtin_amdgcn_readfirstlane(tid >> 6); \
    const int G = gridDim.x, bid = blockIdx.x, gw = bid * NWAVES + wave, NGW = G * NWAVES; \
    unsigned char* ws = ap->ws; unsigned char* dob = (unsigned char*)ap->out; \
    (void)lane; (void)gw; (void)NGW; (void)ws; (void)dob;
#define P_H ((float*)(ws + WS_H))
#define P_HB ((bf16_t*)(dob + DO_HB))
#define P_ACT ((bf16_t*)(ws + WS_ACT))
#define P_Z ((bf16_t*)(ws + WS_Z))
#define P_O ((bf16_t*)(ws + WS_O))
#define P_PQP ((bf16_t*)(ws + WS_PQ))
#define P_PQS ((bf16_t*)(ws + WS_PQ_S))
#define P_SS(i) ((u64*)(ws + WS_SS) + (size_t)(i) * MP)
#define GRID_SYNC() do { __syncthreads(); grid.sync(); } while (0)

__global__ void __launch_bounds__(512, 2) mega_fwd(Args a_unused) {
    extern __shared__ __attribute__((aligned(16))) unsigned char lds_raw[];
    cg::grid_group grid = cg::this_grid();
    LAS unsigned char* lds = (LAS unsigned char*)lds_raw;
    const ArgsP ap0 = (ArgsP)__builtin_amdgcn_kernarg_segment_ptr();

    {
        PHASE_BEGIN
        u64* SS = P_SS(0); float* H = P_H; bf16_t* HB = P_HB;
        LAS float* scr = (LAS float*)(lds + wave * 18432);
        { const size_t n4 = (size_t)12 * MP / 2; f32x4* p = (f32x4*)(SS + MP);
          for (size_t i = (size_t)bid * 512 + tid; i < n4; i += (size_t)G * 512) p[i] = (f32x4){0.f, 0.f, 0.f, 0.f};
          if (bid == 0) for (int i = tid; i < 1024; i += 512) ((unsigned*)(ws + WS_GUARD))[i] = 0u; }
        { const float* xp = ap->in[0]; const float* xs = ap->in[1]; const float* meta = ap->in[2];
        for (int row = gw; row < MP; row += NGW) {
            f32x4 v[4]; float s = 0.f;
            if (row < T) {
                int b, sq; const float* xb;
                if (row < TP) { b = row / LP; sq = row - b * LP; xb = xp + (size_t)b * SEQP * D; } else { const int r = row - TP; b = r / LS; sq = r - b * LS; xb = xs + (size_t)b * SEQS * D; }
                const float* src = sq < NMETA ? meta + (size_t)sq * D : xb + (size_t)(sq - NMETA) * D;
#pragma unroll
                for (int j = 0; j < 4; ++j) { v[j] = *(const f32x4*)(src + 256 * j + 4 * lane); s += (v[j][0] * v[j][0] + v[j][1] * v[j][1]) + (v[j][2] * v[j][2] + v[j][3] * v[j][3]); }
            } else {
#pragma unroll
                for (int j = 0; j < 4; ++j) v[j] = (f32x4){0.f, 0.f, 0.f, 0.f};
            }
            s = wave_sum(s);
#pragma unroll
            for (int j = 0; j < 4; ++j) { *(f32x4*)(H + (size_t)row * D + 256 * j + 4 * lane) = v[j];
                u32x2 w; w.x = cvt_pk_bf16(v[j][0], v[j][1]); w.y = cvt_pk_bf16(v[j][2], v[j][3]); *(u32x2*)(HB + (size_t)row * D + 256 * j + 4 * lane) = w; }
            if (lane == 0) SS[row] = ss_fix(s);
        } }
        {
            bf16_t* TABP = (bf16_t*)(dob + DO_TABP); bf16_t* TABS = (bf16_t*)(dob + DO_TABS);
            const int NP_P = MT_P * (KP_P / 8), NP_S = MT_S * (KP_S / 8);
            for (int p = bid * 512 + tid; p < NP_P + NP_S; p += G * 512) {
                int L, t, k0; bf16_t* dst; float nrm, invL;
                if (p < NP_P) { L = LP; t = p / (KP_P / 8); k0 = (p - t * (KP_P / 8)) * 8; dst = TABP + (size_t)t * KP_P + k0; nrm = 0.00275140752f  ; invL = 1.0f / 2064.0f; }
                else { const int q = p - NP_P; L = LS; t = q / (KP_S / 8); k0 = (q - t * (KP_S / 8)) * 8; dst = TABS + (size_t)t * KP_S + k0; nrm = 0.00194931588f  ; invL = 1.0f / 4112.0f; }
                float vv[8];
                if (t >= L || k0 >= 2 * L) {
#pragma unroll
                    for (int i = 0; i < 8; ++i) vv[i] = 0.f;
                } else {
                    const bool is_sin = k0 >= L; const int kk0 = is_sin ? k0 - L : k0;
                    int mm = (int)(((long long)t * kk0) % L);
#pragma unroll
                    for (int i = 0; i < 8; ++i) { const float fr = (float)mm * invL;
                        vv[i] = is_sin ? -__builtin_amdgcn_sinf(fr) * nrm : __builtin_amdgcn_cosf(fr) * nrm;
                        mm += t; if (mm >= L) mm -= L; }
                }
                u32x4 w; w.x = pk2(vv[0], vv[1]); w.y = pk2(vv[2], vv[3]); w.z = pk2(vv[4], vv[5]); w.w = pk2(vv[6], vv[7]);
                *(u32x4*)dst = w;
            }
        }
        { WPtrs w; w.n1 = ap->in[3]; w.g1 = ap->in[4]; w.u1 = ap->in[5]; w.d1 = ap->in[6]; w.nm = ap->in[7]; w.win = ap->in[8];
          w.nb = nullptr; w.wout = nullptr; w.n2 = nullptr; w.g2 = nullptr; w.u2 = nullptr; w.d2 = nullptr;
          for (int it = gw; it < IT_SETA; it += NGW) wconv_setA(w, ws, it, scr, lane); }
    }
    GRID_SYNC();

#pragma unroll 1
    for (int l = 0; l < DEPTH; ++l) {
        { PHASE_BEGIN
          pg8::Gemm g{P_HB, (const bf16_t*)(ws + WS_WG1), D, D, D}; pg8::StaticOrder S; S.init(MP, 2 * DFF, G, bid);
          EpiSwiGLU E{P_ACT, P_SS(3 * l)}; pg8::gemm_phase<EpiSwiGLU, true>(lds, g, S, E); }
        GRID_SYNC();
        { PHASE_BEGIN
          pg8::Gemm g{P_ACT, (const bf16_t*)(ws + WS_WD1), DFF, DFF, DFF}; pg8::StaticOrder S; S.init(MP, D, G, bid);
          EpiDown E{P_H, P_HB, P_SS(3 * l + 1), 0.5f}; pg8::gemm_phase<EpiDown, true>(lds, g, S, E); }
        GRID_SYNC();
        { PHASE_BEGIN
          pg8::Gemm g{P_HB, (const bf16_t*)(ws + WS_WIN), D, D, D}; pg8::StaticOrder S; S.init(MP, DZ, G, bid);
          EpiZ E{P_Z, P_SS(3 * l + 1)}; pg8::gemm_phase<EpiZ, true>(lds, g, S, E); }
        __syncthreads();
        { PHASE_BEGIN
          pg8::Gemm g{(const bf16_t*)(ws + WS_WPQ), P_HB, D, D, D}; pg8::StaticOrder S; S.init(512, MP, G, bid);
          EpiPQ E{P_PQP, P_PQS, P_SS(3 * l + 1)}; pg8::gemm_phase<EpiPQ, true>(lds, g, S, E); }
        GRID_SYNC();
#ifndef SKIP_ATT
        { PHASE_BEGIN
          const float* sink_l = ap->in[13] + l * 8; const bf16_t* Z = P_Z; bf16_t* O = P_O;
          for (int u = bid; u < N_ATT_UNITS; u += G) { int b, qt; unit_decode(u, b, qt); attn_unit(lds, Z, O, sink_l, b, qt, tid); }
        }
        __syncthreads();
#endif
#ifndef SKIP_CONV
        { PHASE_BEGIN
          const bf16_t* Z = P_Z; bf16_t* O = P_O;
          const int c = tid & 255; float w[31];
          const float* wdw = ap->in[9] + (size_t)l * 31 * 256;
#pragma unroll
          for (int j = 0; j < 31; ++j) w[j] = wdw[j * 256 + c];
          const float bias = ap->in[10][l * 256 + c];
          const f32x4 lng = *(const f32x4*)(ap->in[11] + l * 256 + 4 * lane), lnb = *(const f32x4*)(ap->in[12] + l * 256 + 4 * lane);
          for (int u = (G - 1 - bid); u < N_ATT_UNITS; u += G) { int b, qt; unit_decode(u, b, qt); conv_unit(lds, Z, O, w, bias, lng, lnb, b, qt, tid); }
        }
        __syncthreads();
#endif
        { PHASE_BEGIN
          LAS float* scr = (LAS float*)(lds + wave * 18432);
          WPtrs w;
          w.nb = ap->in[14] + (size_t)l * D; w.wout = ap->in[15] + (size_t)l * D * D; w.n2 = ap->in[16] + (size_t)l * D;
          w.g2 = ap->in[17] + (size_t)l * D * DFF; w.u2 = ap->in[18] + (size_t)l * D * DFF; w.d2 = ap->in[19] + (size_t)l * D * DFF;
          const int ln = l + 1 < DEPTH ? l + 1 : l;
          w.n1 = ap->in[3] + (size_t)ln * D; w.g1 = ap->in[4] + (size_t)ln * D * DFF; w.u1 = ap->in[5] + (size_t)ln * D * DFF; w.d1 = ap->in[6] + (size_t)ln * D * DFF;
          w.nm = ap->in[7] + (size_t)ln * D; w.win = ap->in[8] + (size_t)ln * D * DIN;
          for (int it = gw; it < IT_SETB; it += NGW) wconv_setB(w, ws, it, scr, lane);
          if (l + 1 < DEPTH) for (int it = gw; it < IT_SETA; it += NGW) wconv_setA(w, ws, it, scr, lane);
        }
        GRID_SYNC();
        { PHASE_BEGIN
          pg8::Gemm g{(const bf16_t*)(dob + DO_TABP), P_PQP, KP_P, LDB_P, KP_P}; pg8::StaticOrder S; S.init(MT_P, NBP * 256, G, bid);
          EpiDFT E{P_O, LP, 0}; pg8::gemm_phase<EpiDFT, false>(lds, g, S, E); }
        __syncthreads();
        { PHASE_BEGIN
          pg8::Gemm g{(const bf16_t*)(dob + DO_TABS), P_PQS, KP_S, LDB_S, KP_S}; pg8::StaticOrder S; S.init(MT_S, NBS * 256, G, (bid + G - 144) % G);
          EpiDFT E{P_O, LS, TP}; pg8::gemm_phase<EpiDFT, false>(lds, g, S, E); }
        GRID_SYNC();
        { PHASE_BEGIN
          pg8::Gemm g{P_O, (const bf16_t*)(ws + WS_WOUT), D, D, D}; pg8::StaticOrder S; S.init(MP, D, G, bid);
          EpiDown E{P_H, P_HB, P_SS(3 * l + 2), 1.0f}; pg8::gemm_phase<EpiDown, true>(lds, g, S, E); }
        GRID_SYNC();
        { PHASE_BEGIN
          pg8::Gemm g{P_HB, (const bf16_t*)(ws + WS_WG2), D, D, D}; pg8::StaticOrder S; S.init(MP, 2 * DFF, G, bid);
          EpiSwiGLU E{P_ACT, P_SS(3 * l + 2)}; pg8::gemm_phase<EpiSwiGLU, true>(lds, g, S, E); }
        GRID_SYNC();
        { PHASE_BEGIN
          pg8::Gemm g{P_ACT, (const bf16_t*)(ws + WS_WD2), DFF, DFF, DFF}; pg8::StaticOrder S; S.init(MP, D, G, bid);
          EpiDown E{P_H, P_HB, P_SS(3 * l + 3), 0.5f}; pg8::gemm_phase<EpiDown, true>(lds, g, S, E); }
        GRID_SYNC();
    }
    {
        PHASE_BEGIN
        const float* fn = ap->in[20]; const float* H = P_H; float* outp = ap->out;
        f32x4 gn[4];
#pragma unroll
        for (int j = 0; j < 4; ++j) gn[j] = *(const f32x4*)(fn + 256 * j + 4 * lane);
        const int NR = NBP * SEQP + NBS * SEQS;
        for (int r = gw; r < NR; r += NGW) {
            int row;
            if (r < NBP * SEQP) { const int b = r / SEQP, s = r - b * SEQP; row = b * LP + NMETA + s; } else { const int q = r - NBP * SEQP, b = q / SEQS, s = q - b * SEQS; row = TP + b * LS + NMETA + s; }
            f32x4 v[4]; float s2 = 0.f;
#pragma unroll
            for (int j = 0; j < 4; ++j) { v[j] = *(const f32x4*)(H + (size_t)row * D + 256 * j + 4 * lane); s2 += (v[j][0] * v[j][0] + v[j][1] * v[j][1]) + (v[j][2] * v[j][2] + v[j][3] * v[j][3]); }
            const float rr = rs1024f(wave_sum(s2));
#pragma unroll
            for (int j = 0; j < 4; ++j) *(f32x4*)(outp + (size_t)r * D + 256 * j + 4 * lane) = v[j] * rr * gn[j];
        }
    }
}

extern "C" void kernel_launch(void* const* d_in, const int* in_sizes, int n_in, void* d_out, int out_size, void* d_ws, size_t ws_size, hipStream_t stream) {
    static int grid = 0;
    if (grid == 0) {
        int dev = 0, cus = 0, per_cu = 0;
        (void)hipGetDevice(&dev);
        (void)hipDeviceGetAttribute(&cus, hipDeviceAttributeMultiprocessorCount, dev);
        (void)hipFuncSetAttribute((const void*)mega_fwd, hipFuncAttributeMaxDynamicSharedMemorySize, LDS_BYTES);
        (void)hipOccupancyMaxActiveBlocksPerMultiprocessor(&per_cu, (const void*)mega_fwd, 512, LDS_BYTES);
        if (per_cu < 1) per_cu = 1;
        grid = cus * 1;
        if (ws_size < WS_END) { fprintf(stderr, "kernel_launch: workspace too small: %zu < %zu\n", ws_size, (size_t)WS_END); }
    }
    Args a{};
    for (int i = 0; i < 21; ++i) a.in[i] = (const float*)d_in[i];
    a.out = (float*)d_out; a.ws = (unsigned char*)d_ws;
    void* args[] = {&a};
    hipError_t e = hipLaunchCooperativeKernel((const void*)mega_fwd, dim3(grid), dim3(512), args, LDS_BYTES, stream);
    if (e != hipSuccess) fprintf(stderr, "cooperative launch failed: %s (grid %d)\n", hipGetErrorString(e), grid);
}
```

```cpp
#include <hip/hip_runtime.h>
#include <hip/hip_cooperative_groups.h>
#include <cstdint>
#include <cstdio>
namespace cg = cooperative_groups;

#define LAS __attribute__((address_space(3)))
typedef unsigned short bf16_t;
typedef short bf16x8 __attribute__((ext_vector_type(8)));
typedef short s16x4 __attribute__((ext_vector_type(4)));
typedef float f32x4 __attribute__((ext_vector_type(4)));
typedef unsigned u32x4 __attribute__((ext_vector_type(4)));
typedef unsigned u32x2 __attribute__((ext_vector_type(2)));

constexpr int D = 1024, DFF = 2816, DEPTH = 4;
constexpr int LP = 2064, LS = 4112, NBP = 16, NBS = 4, NMETA = 16, SEQP = 2048, SEQS = 4096;
constexpr int TP = NBP * LP;
constexpr int TS = NBS * LS;
constexpr int T = TP + TS;
constexpr int MP = 49664;
constexpr int DZ = 1280;
constexpr int DIN = 1536;
constexpr int KP_P = 4224, KP_S = 8320;
constexpr int MT_P = 2304, MT_S = 4352;
constexpr int LDB_P = 2 * LP, LDB_S = 2 * LS;
constexpr float EPS = 1e-6f;

constexpr size_t WS_H = 0;
constexpr size_t WS_ACT = WS_H + (size_t)MP * D * 4;
constexpr size_t WS_Z = WS_ACT;
constexpr size_t WS_O = WS_Z + (size_t)MP * DZ * 2;
constexpr size_t WS_PQ = WS_O + (size_t)MP * D * 2;
constexpr size_t WS_PQ_S = WS_PQ + (size_t)NBP * 256 * LDB_P * 2;
constexpr size_t WS_PQ_END = WS_PQ_S + (size_t)NBS * 256 * LDB_S * 2;
constexpr size_t WS_TAIL = WS_ACT + (size_t)MP * DFF * 2;
static_assert(WS_PQ_END <= WS_TAIL, "PQ overlay");
constexpr size_t WS_GUARD = WS_TAIL;
constexpr size_t WS_SS = WS_GUARD + 4096;
constexpr size_t WS_WG1 = WS_SS + (size_t)13 * MP * 8;
constexpr size_t WS_WD1 = WS_WG1 + (size_t)2 * DFF * D * 2;
constexpr size_t WS_WIN = WS_WD1 + (size_t)D * DFF * 2;
constexpr size_t WS_WPQ = WS_WIN + (size_t)DZ * D * 2;
constexpr size_t WS_WOUT = WS_WPQ + (size_t)512 * D * 2;
constexpr size_t WS_WG2 = WS_WOUT + (size_t)D * D * 2;
constexpr size_t WS_WD2 = WS_WG2 + (size_t)2 * DFF * D * 2;
constexpr size_t WS_END = WS_WD2 + (size_t)D * DFF * 2;
constexpr size_t WS_BAR = (WS_END + 4095) & ~(size_t)4095;
constexpr size_t WS_BAR_BYTES = 16384;
static_assert(WS_BAR + WS_BAR_BYTES <= (size_t)512 * 1024 * 1024, "workspace");
constexpr size_t DO_HB = 0;
constexpr size_t DO_TABP = DO_HB + (size_t)MP * D * 2;
constexpr size_t DO_TABS = DO_TABP + (size_t)MT_P * KP_P * 2;
constexpr size_t DO_END = DO_TABS + (size_t)MT_S * KP_S * 2;
static_assert(DO_END <= (size_t)(NBP * SEQP + NBS * SEQS) * D * 4, "d_out scratch");

constexpr int LDS_MISC = 147456;
constexpr int LDS_BYTES = 147456 + 256;
constexpr int NWAVES = 8;

__device__ __forceinline__ unsigned cvt_pk_bf16(float lo, float hi) { unsigned r; asm volatile("v_cvt_pk_bf16_f32 %0, %1, %2" : "=v"(r) : "v"(lo), "v"(hi)); return r; }
__device__ __forceinline__ unsigned f2bf(float f) { unsigned u = __builtin_bit_cast(unsigned, f); return (u + 0x7fffu + ((u >> 16) & 1u)) >> 16; }
__device__ __forceinline__ unsigned pk2(float lo, float hi) { return f2bf(lo) | (f2bf(hi) << 16); }
__device__ __forceinline__ float bf_lo(unsigned w) { return __builtin_bit_cast(float, w << 16); }
__device__ __forceinline__ float bf_hi(unsigned w) { return __builtin_bit_cast(float, w & 0xffff0000u); }
__device__ __forceinline__ float xsum16(float v) { const unsigned u = __builtin_bit_cast(unsigned, v); auto r = __builtin_amdgcn_permlane16_swap(u, u, false, false); return __builtin_bit_cast(float, (unsigned)r[0]) + __builtin_bit_cast(float, (unsigned)r[1]); }
__device__ __forceinline__ float xsum32(float v) { const unsigned u = __builtin_bit_cast(unsigned, v); auto r = __builtin_amdgcn_permlane32_swap(u, u, false, false); return __builtin_bit_cast(float, (unsigned)r[0]) + __builtin_bit_cast(float, (unsigned)r[1]); }
__device__ __forceinline__ float xmax16(float v) { const unsigned u = __builtin_bit_cast(unsigned, v); auto r = __builtin_amdgcn_permlane16_swap(u, u, false, false); return fmaxf(__builtin_bit_cast(float, (unsigned)r[0]), __builtin_bit_cast(float, (unsigned)r[1])); }
__device__ __forceinline__ float xmax32(float v) { const unsigned u = __builtin_bit_cast(unsigned, v); auto r = __builtin_amdgcn_permlane32_swap(u, u, false, false); return fmaxf(__builtin_bit_cast(float, (unsigned)r[0]), __builtin_bit_cast(float, (unsigned)r[1])); }
__device__ __forceinline__ float xsum_q(float v) { return xsum32(xsum16(v)); }
__device__ __forceinline__ float wave_sum(float v) {
#pragma unroll
    for (int o = 1; o < 16; o <<= 1) v += __shfl_xor(v, o);
    return xsum_q(v);
}
typedef unsigned long long u64;
typedef u64 u64x2 __attribute__((ext_vector_type(2)));
__device__ __forceinline__ float rs1024f(float ss) { return __builtin_amdgcn_rsqf(ss * (1.0f / 1024.0f) + EPS); }
__device__ __forceinline__ float rs1024(u64 ss) { return __builtin_amdgcn_rsqf((float)ss * (1.0f / (16777216.0f * 1024.0f)) + EPS); }
__device__ __forceinline__ u64 ss_fix(float q) { return (u64)(q * 16777216.0f); }
#define LDS_WAIT() asm volatile("s_waitcnt lgkmcnt(0)" ::: "memory")

namespace pg8 {
constexpr int BM = 256, BK = 64, HALF = 128, HTB = HALF * BK * 2, STAGE_BYTES = 8 * HTB, NXCD = 8, WGM = 8;
__host__ __device__ __forceinline__ int lds_byte(int r, int c) { const int st = (r >> 4) * 2 + (c >> 5), rr = r & 15, cc = c & 31, ob = rr * 64 + cc * 2; return st * 1024 + (ob ^ (((ob >> 9) & 1) << 5)); }
__host__ __device__ __forceinline__ void stage_rc(int b, int& R, int& C) { const int st = b / 1024, sb = b % 1024, swz = sb ^ (((sb >> 9) & 1) << 5); R = (st >> 1) * 16 + swz / 64; C = (st & 1) * 32 + (swz % 64) / 2; }
__host__ __device__ __forceinline__ int perm32(int rho) { const int n = rho >> 4, i = rho & 15; return 8 * (i >> 2) + 4 * n + (i & 3); }

struct Unit { int pm, pn; };
struct Gemm { const bf16_t* A; const bf16_t* Bt; int lda, ldb, K; };

struct StaticOrder {
    int nM, nN, nwg, G, c;
    __device__ void init(int M, int N, int G_, int c_) { nM = M / BM; nN = N / BM; nwg = nM * nN; G = G_; c = c_; }
    __device__ bool next(int i, Unit& u) const {
        const long L = (long)i * G + c; if (L >= nwg) return false;
        int wgid = (int)L; { const int q = nwg / NXCD, r = nwg % NXCD, xcd = wgid % NXCD, off = wgid / NXCD; wgid = (xcd < r ? xcd * (q + 1) : r * (q + 1) + (xcd - r) * q) + off; }
        const int nig = WGM * nN, gid = wgid / nig, fm = gid * WGM, gsz = (nM - fm) < WGM ? (nM - fm) : WGM;
        u.pm = fm + ((wgid % nig) % gsz); u.pn = (wgid % nig) / gsz; return true;
    }
};

template <class Epi, bool ALIGN_EPI>
__device__ __forceinline__ void gemm_phase(LAS unsigned char* lds, const Gemm g, const StaticOrder& S, const Epi& E) {
    int tid_ = threadIdx.x; asm volatile("" : "+v"(tid_));
    const int tid = tid_, wid = __builtin_amdgcn_readfirstlane(tid >> 6), lane = tid & 63, wr = wid >> 2, wc = wid & 3, fr = lane & 15, fq = lane >> 4;
    const int nt = g.K / BK;
    unsigned voffA[2], voffB[2];
#pragma unroll
    for (int i = 0; i < 2; ++i) { int R, C; stage_rc(tid * 16 + i * 8192, R, C); const int Rb = Epi::PERM ? ((R & ~31) + perm32(R & 31)) : R;
        voffA[i] = (unsigned)(R * g.lda + C) * 2u; voffB[i] = (unsigned)(Rb * g.ldb + C) * 2u; }
    const size_t kstep = (size_t)(BK * 2);
    const size_t hstepA = (size_t)HALF * g.lda * 2, hstepB = (size_t)HALF * g.ldb * 2;
    const size_t tstepA = 2 * hstepA, tstepB = 2 * hstepB;
    const unsigned ldsw = (unsigned)wid * 1024u;
    const int aoff = lds_byte(wr * 64 + fr, fq * 8), boff = lds_byte(wc * 32 + fr, fq * 8);
#define PG8_SA(b, h) (((b) * 2 + (h)) * HTB)
#define PG8_SB(b, h) ((4 + (b) * 2 + (h)) * HTB)
#define PG8_STAGE(bufoff, gbase, voff) do { _Pragma("unroll") for (int _i = 0; _i < 2; ++_i) \
        __builtin_amdgcn_global_load_lds((const unsigned*)((const char*)(gbase) + (voff)[_i]), (LAS unsigned*)(lds + (bufoff) + ldsw + _i * 8192), 16, 0, 0); } while (0)
#define PG8_LDA(dst, b, h) do { _Pragma("unroll") for (int m = 0; m < 4; ++m) _Pragma("unroll") for (int k = 0; k < 2; ++k) dst[m][k] = *(const LAS bf16x8*)(lds + PG8_SA(b, h) + aoff + m * 2048 + k * 1024); } while (0)
#define PG8_LDB(dst, b, h) do { _Pragma("unroll") for (int n = 0; n < 2; ++n) _Pragma("unroll") for (int k = 0; k < 2; ++k) dst[n][k] = *(const LAS bf16x8*)(lds + PG8_SB(b, h) + boff + n * 2048 + k * 1024); } while (0)
#define PG8_MMA(ai, bj, At, Bt) do { __builtin_amdgcn_s_setprio(1); _Pragma("unroll") for (int m = 0; m < 4; ++m) _Pragma("unroll") for (int n = 0; n < 2; ++n) _Pragma("unroll") for (int k = 0; k < 2; ++k) \
        acc[ai][bj][m][n] = __builtin_amdgcn_mfma_f32_16x16x32_bf16(Bt[n][k], At[m][k], acc[ai][bj][m][n], 0, 0, 0); __builtin_amdgcn_s_setprio(0); } while (0)
#define PG8_WAIT_V(n) asm volatile("s_waitcnt vmcnt(" #n ")" ::: "memory")
#define PG8_WAIT_L(n) asm volatile("s_waitcnt lgkmcnt(" #n ")" ::: "memory")
#define PG8_BAR __builtin_amdgcn_s_barrier()
#define PG8_SCHED __builtin_amdgcn_sched_barrier(0)
    Unit cur, nxt; int ui = 0;
    if (!S.next(0, cur)) return;
    f32x4 acc[2][2][4][2];
#pragma unroll
    for (int a = 0; a < 2; ++a)
#pragma unroll
        for (int b = 0; b < 2; ++b)
#pragma unroll
            for (int m = 0; m < 4; ++m)
#pragma unroll
                for (int n = 0; n < 2; ++n) acc[a][b][m][n] = (f32x4){0.f, 0.f, 0.f, 0.f};
    bf16x8 At[4][2], B0[2][2], B1[2][2];
    const char* cA = (const char*)g.A + (size_t)cur.pm * tstepA; const char* cB = (const char*)g.Bt + (size_t)cur.pn * tstepB;
    PG8_STAGE(PG8_SB(0, 0), cB, voffB); PG8_STAGE(PG8_SB(0, 1), cB + hstepB, voffB); PG8_STAGE(PG8_SA(0, 0), cA, voffA); PG8_STAGE(PG8_SA(0, 1), cA + hstepA, voffA);
    if (wr == 1) PG8_BAR;
    PG8_WAIT_V(2); PG8_BAR;
    PG8_STAGE(PG8_SB(1, 0), cB + kstep, voffB); PG8_STAGE(PG8_SA(1, 0), cA + kstep, voffA); PG8_STAGE(PG8_SB(1, 1), cB + hstepB + kstep, voffB);
    PG8_WAIT_V(6); PG8_BAR;
    for (;;) {
        const bool has_next = S.next(ui + 1, nxt);
        const char* nA = has_next ? (const char*)g.A + (size_t)nxt.pm * tstepA : cA; const char* nB = has_next ? (const char*)g.Bt + (size_t)nxt.pn * tstepB : cB;
        for (int t = 0; t < nt; t += 2) {
            const bool last = (t == nt - 2);
            const char* a1 = cA + (size_t)(t + 1) * kstep;
            const char* a2 = last ? nA : cA + (size_t)(t + 2) * kstep; const char* b2 = last ? nB : cB + (size_t)(t + 2) * kstep;
            const char* a3 = a2 + kstep; const char* b3 = b2 + kstep;
            PG8_LDB(B0, 0, 0); PG8_LDB(B1, 0, 1); PG8_SCHED; PG8_LDA(At, 0, 0); PG8_STAGE(PG8_SA(1, 1), a1 + hstepA, voffA);
            PG8_WAIT_V(8); PG8_WAIT_L(0); PG8_BAR; PG8_MMA(0, 0, At, B0); PG8_MMA(0, 1, At, B1); PG8_BAR; PG8_SCHED;
            PG8_LDA(At, 0, 1); PG8_STAGE(PG8_SB(0, 0), b2, voffB); PG8_STAGE(PG8_SB(0, 1), b2 + hstepB, voffB); PG8_STAGE(PG8_SA(0, 0), a2, voffA);
            PG8_WAIT_V(8); PG8_WAIT_L(0); PG8_BAR; PG8_MMA(1, 0, At, B0); PG8_MMA(1, 1, At, B1); PG8_BAR; PG8_SCHED;
            PG8_LDB(B0, 1, 0); PG8_LDB(B1, 1, 1); PG8_SCHED; PG8_LDA(At, 1, 0); PG8_STAGE(PG8_SA(0, 1), a2 + hstepA, voffA);
            PG8_WAIT_V(8); PG8_WAIT_L(0); PG8_BAR; PG8_MMA(0, 0, At, B0); PG8_MMA(0, 1, At, B1); PG8_BAR; PG8_SCHED;
            PG8_LDA(At, 1, 1); PG8_STAGE(PG8_SB(1, 0), b3, voffB); PG8_STAGE(PG8_SB(1, 1), b3 + hstepB, voffB); PG8_STAGE(PG8_SA(1, 0), a3, voffA);
            PG8_WAIT_V(8); PG8_WAIT_L(0); PG8_BAR; PG8_MMA(1, 0, At, B0); PG8_MMA(1, 1, At, B1); PG8_BAR; PG8_SCHED;
        }
        if constexpr (ALIGN_EPI) { if (wr == 0) PG8_BAR; }
        if constexpr (!Epi::AFTER_DRAIN) { E(acc, cur, wr, wc, fr, fq); }
        if (!has_next) break;
#pragma unroll
        for (int a = 0; a < 2; ++a)
#pragma unroll
            for (int b = 0; b < 2; ++b)
#pragma unroll
                for (int m = 0; m < 4; ++m)
#pragma unroll
                    for (int n = 0; n < 2; ++n) acc[a][b][m][n] = (f32x4){0.f, 0.f, 0.f, 0.f};
        cur = nxt; cA = nA; cB = nB; ++ui;
        if constexpr (ALIGN_EPI) { if (wr == 1) PG8_BAR; }
    }
    PG8_WAIT_V(0);
    if constexpr (!ALIGN_EPI) { if (wr == 0) PG8_BAR; }
    PG8_BAR;
    if constexpr (Epi::AFTER_DRAIN) { E.fused(acc, cur, wr, wc, fr, fq, lds); }
#undef PG8_SA
#undef PG8_SB
#undef PG8_STAGE
#undef PG8_LDA
#undef PG8_LDB
#undef PG8_MMA
#undef PG8_WAIT_V
#undef PG8_WAIT_L
#undef PG8_BAR
#undef PG8_SCHED
}
}

__device__ __forceinline__ float silu_mul(float g, float u) { return g * u * __builtin_amdgcn_rcpf(1.0f + __expf(-g)); }

struct EpiSwiGLU {
    static constexpr bool PERM = true, AFTER_DRAIN = false;
    bf16_t* act; const u64* ss;
    __device__ __forceinline__ void operator()(const f32x4 (&acc)[2][2][4][2], const pg8::Unit& u, int wr, int wc, int fr, int fq) const {
        const int row0 = u.pm * 256 + wr * 64 + fr, col0 = u.pn * 128 + wc * 32 + 8 * fq;
#pragma unroll
        for (int ai = 0; ai < 2; ++ai)
#pragma unroll
            for (int m = 0; m < 4; ++m) {
                const int row = row0 + ai * 128 + m * 16; const float r = rs1024(ss[row]);
                const f32x4 g0 = acc[ai][0][m][0] * r, g1 = acc[ai][0][m][1] * r, u0 = acc[ai][1][m][0] * r, u1 = acc[ai][1][m][1] * r;
                u32x4 w;
                w.x = cvt_pk_bf16(silu_mul(g0[0], u0[0]), silu_mul(g0[1], u0[1])); w.y = cvt_pk_bf16(silu_mul(g0[2], u0[2]), silu_mul(g0[3], u0[3]));
                w.z = cvt_pk_bf16(silu_mul(g1[0], u1[0]), silu_mul(g1[1], u1[1])); w.w = cvt_pk_bf16(silu_mul(g1[2], u1[2]), silu_mul(g1[3], u1[3]));
                *(u32x4*)(act + (size_t)row * DFF + col0) = w;
            }
    }
};
struct EpiDown {
    static constexpr bool PERM = true, AFTER_DRAIN = false;
    float* H; bf16_t* HB; u64* ssn; float alpha;
    __device__ __forceinline__ void operator()(const f32x4 (&acc)[2][2][4][2], const pg8::Unit& u, int wr, int wc, int fr, int fq) const {
        const int row0 = u.pm * 256 + wr * 64 + fr, col0 = u.pn * 256 + wc * 32 + 8 * fq;
#pragma unroll
        for (int ai = 0; ai < 2; ++ai)
#pragma unroll
            for (int m = 0; m < 4; ++m) {
                const int row = row0 + ai * 128 + m * 16; float* hp = H + (size_t)row * D + col0; bf16_t* bp = HB + (size_t)row * D + col0;
                float q = 0.f;
#pragma unroll
                for (int bj = 0; bj < 2; ++bj) {
                    f32x4 a0 = *(const f32x4*)(hp + bj * 128), a1 = *(const f32x4*)(hp + bj * 128 + 4);
                    a0 = a0 + acc[ai][bj][m][0] * alpha; a1 = a1 + acc[ai][bj][m][1] * alpha;
                    *(f32x4*)(hp + bj * 128) = a0; *(f32x4*)(hp + bj * 128 + 4) = a1;
                    q += (a0[0] * a0[0] + a0[1] * a0[1]) + (a0[2] * a0[2] + a0[3] * a0[3]) + (a1[0] * a1[0] + a1[1] * a1[1]) + (a1[2] * a1[2] + a1[3] * a1[3]);
                    u32x4 w; w.x = cvt_pk_bf16(a0[0], a0[1]); w.y = cvt_pk_bf16(a0[2], a0[3]); w.z = cvt_pk_bf16(a1[0], a1[1]); w.w = cvt_pk_bf16(a1[2], a1[3]);
                    *(u32x4*)(bp + bj * 128) = w;
                }
                q = xsum_q(q);
                if (fq == 0) atomicAdd(ssn + row, ss_fix(q));
                asm volatile("" ::: "memory");
            }
    }
};
struct EpiZ {
    static constexpr bool PERM = true, AFTER_DRAIN = false;
    bf16_t* Z; const u64* ss;
    __device__ __forceinline__ void operator()(const f32x4 (&acc)[2][2][4][2], const pg8::Unit& u, int wr, int wc, int fr, int fq) const {
        const int row0 = u.pm * 256 + wr * 64 + fr, col0 = u.pn * 256 + wc * 32 + 8 * fq;
#pragma unroll
        for (int ai = 0; ai < 2; ++ai)
#pragma unroll
            for (int m = 0; m < 4; ++m) {
                const int row = row0 + ai * 128 + m * 16; const float r = rs1024(ss[row]); bf16_t* zp = Z + (size_t)row * DZ + col0;
#pragma unroll
                for (int bj = 0; bj < 2; ++bj) {
                    const f32x4 a0 = acc[ai][bj][m][0] * r, a1 = acc[ai][bj][m][1] * r;
                    u32x4 w; w.x = cvt_pk_bf16(a0[0], a0[1]); w.y = cvt_pk_bf16(a0[2], a0[3]); w.z = cvt_pk_bf16(a1[0], a1[1]); w.w = cvt_pk_bf16(a1[2], a1[3]);
                    *(u32x4*)(zp + bj * 128) = w;
                }
            }
    }
};
struct EpiPQ {
    static constexpr bool PERM = true, AFTER_DRAIN = false;
    bf16_t* PQP; bf16_t* PQS; const u64* ss;
    __device__ __forceinline__ void operator()(const f32x4 (&acc)[2][2][4][2], const pg8::Unit& u, int wr, int wc, int fr, int fq) const {
        const int ch0 = wr * 64 + fr;
#pragma unroll
        for (int bj = 0; bj < 2; ++bj) {
            const int tok = u.pn * 256 + bj * 128 + wc * 32 + 8 * fq;
            if (tok < T) {
                bf16_t* base; int L2;
                if (tok < TP) { const int b = tok / LP, s = tok - b * LP; base = PQP + (size_t)b * 256 * LDB_P + u.pm * LP + s; L2 = LDB_P; }
                else { const int tt = tok - TP, b = tt / LS, s = tt - b * LS; base = PQS + (size_t)b * 256 * LDB_S + u.pm * LS + s; L2 = LDB_S; }
                f32x4 r0, r1;
#pragma unroll
                for (int j = 0; j < 2; ++j) { const u64x2 sa = *(const u64x2*)(ss + tok + 2 * j), sb2 = *(const u64x2*)(ss + tok + 4 + 2 * j);
                    r0[2 * j] = rs1024(sa[0]); r0[2 * j + 1] = rs1024(sa[1]); r1[2 * j] = rs1024(sb2[0]); r1[2 * j + 1] = rs1024(sb2[1]); }
#pragma unroll
                for (int ai = 0; ai < 2; ++ai)
#pragma unroll
                    for (int m = 0; m < 4; ++m) {
                        const int c = ch0 + ai * 128 + m * 16;
                        const f32x4 a0 = acc[ai][bj][m][0] * r0, a1 = acc[ai][bj][m][1] * r1;
                        u32x4 w; w.x = cvt_pk_bf16(a0[0], a0[1]); w.y = cvt_pk_bf16(a0[2], a0[3]); w.z = cvt_pk_bf16(a1[0], a1[1]); w.w = cvt_pk_bf16(a1[2], a1[3]);
                        *(u32x4*)(base + (size_t)c * L2) = w;
                    }
            }
        }
    }
};
struct EpiDFT {
    static constexpr bool PERM = true, AFTER_DRAIN = true;
    bf16_t* O; int L, rowoff;
    __device__ __forceinline__ void operator()(const f32x4 (&)[2][2][4][2], const pg8::Unit&, int, int, int, int) const {}
    __device__ __forceinline__ void fused(const f32x4 (&acc)[2][2][4][2], const pg8::Unit& u, int wr, int wc, int fr, int fq, LAS unsigned char* lds) const {
        LAS float* P = (LAS float*)lds;
#pragma unroll
        for (int ai = 0; ai < 2; ++ai)
#pragma unroll
            for (int m = 0; m < 4; ++m) {
                float q = 0.f;
#pragma unroll
                for (int bj = 0; bj < 2; ++bj)
#pragma unroll
                    for (int n = 0; n < 2; ++n) { const f32x4 x = acc[ai][bj][m][n]; q += (x[0] * x[0] + x[1] * x[1]) + (x[2] * x[2] + x[3] * x[3]); }
                q = xsum_q(q);
                if (fq == 0) P[(ai * 128 + wr * 64 + m * 16 + fr) * 4 + wc] = q;
            }
        LDS_WAIT(); __builtin_amdgcn_s_barrier(); asm volatile("" ::: "memory");
#pragma unroll
        for (int ai = 0; ai < 2; ++ai)
#pragma unroll
            for (int m = 0; m < 4; ++m) {
                const int rl = ai * 128 + wr * 64 + m * 16 + fr; const f32x4 pp = *(const LAS f32x4*)(P + rl * 4);
                const float rinv = __builtin_amdgcn_rsqf(((pp[0] + pp[1]) + (pp[2] + pp[3])) * (1.0f / 256.0f) + EPS);
                const int t = u.pm * 256 + rl;
                if (t < L) {
                    bf16_t* op = O + (size_t)(rowoff + u.pn * L + t) * D + 512 + wc * 32 + 8 * fq;
#pragma unroll
                    for (int bj = 0; bj < 2; ++bj) {
                        const f32x4 a0 = acc[ai][bj][m][0] * rinv, a1 = acc[ai][bj][m][1] * rinv;
                        u32x4 w; w.x = cvt_pk_bf16(a0[0], a0[1]); w.y = cvt_pk_bf16(a0[2], a0[3]); w.z = cvt_pk_bf16(a1[0], a1[1]); w.w = cvt_pk_bf16(a1[2], a1[3]);
                        *(u32x4*)(op + bj * 128) = w;
                    }
                }
            }
        LDS_WAIT(); __builtin_amdgcn_s_barrier(); asm volatile("" ::: "memory");
    }
};

__device__ __forceinline__ void tr_item(const float* W, int ldw, int k0, int nc0, const float* gain, bf16_t* WT, int ldo, int drow0, LAS float* scr, int lane) {
#pragma unroll 8
    for (int i = 0; i < 32; ++i) { const int kk = 2 * i + (lane >> 5); const float gsc = gain ? gain[k0 + kk] : 1.0f;
        scr[kk * 33 + (lane & 31)] = W[(size_t)(k0 + kk) * ldw + nc0 + (lane & 31)] * gsc; }
    LDS_WAIT(); asm volatile("" ::: "memory");
    const int c = lane & 7;
#pragma unroll
    for (int j = 0; j < 4; ++j) { const int n = (lane >> 3) + 8 * j; const LAS float* s = scr + (8 * c) * 33 + n;
        u32x4 o; o.x = pk2(s[0 * 33], s[1 * 33]); o.y = pk2(s[2 * 33], s[3 * 33]); o.z = pk2(s[4 * 33], s[5 * 33]); o.w = pk2(s[6 * 33], s[7 * 33]);
        *(u32x4*)(WT + (size_t)(drow0 + n) * ldo + k0 + 8 * c) = o; }
    LDS_WAIT(); asm volatile("" ::: "memory");
}
__device__ __forceinline__ void wpq_item(const float* Win, const float* gain, bf16_t* WPQ, int item, LAS float* scr, int lane) {
    const int kb = item >> 4, G = (item >> 2) & 3, cq = item & 3, k0 = kb * 64;
    LAS float* tab = scr + 64 * 65;
    tab[lane] = __builtin_amdgcn_cosf((float)lane * (1.0f / 64.0f)); tab[64 + lane] = __builtin_amdgcn_sinf((float)lane * (1.0f / 64.0f));
#pragma unroll 8
    for (int i = 0; i < 64; ++i) scr[lane * 65 + i] = Win[(size_t)(k0 + i) * DIN + 768 + 64 * G + lane] * gain[k0 + i];
    LDS_WAIT(); asm volatile("" ::: "memory");
    for (int cc = 0; cc < 16; ++cc) {
        const int cp = 16 * cq + cc; float aP = 0.f, aQ = 0.f; int idx = 0;
#pragma unroll 8
        for (int c = 0; c < 64; ++c) { const float v = scr[c * 65 + lane]; aP += v * tab[idx]; aQ += v * tab[64 + idx]; idx = (idx + cp) & 63; }
        WPQ[(size_t)(64 * G + cp) * D + k0 + lane] = (bf16_t)f2bf(aP);
        WPQ[(size_t)(256 + 64 * G + cp) * D + k0 + lane] = (bf16_t)f2bf(aQ);
    }
    LDS_WAIT(); asm volatile("" ::: "memory");
}
struct WPtrs { const float *n1, *g1, *u1, *d1, *nm, *win, *nb, *wout, *n2, *g2, *u2, *d2; };
constexpr int IT_GATE = 16 * 88, IT_DOWN = 44 * 32, IT_WIN = 16 * 40, IT_WPQ = 256, IT_WOUT = 16 * 32;
constexpr int IT_SETA = 2 * IT_GATE + IT_DOWN + IT_WIN + IT_WPQ;
constexpr int IT_SETB = IT_WOUT + 2 * IT_GATE + IT_DOWN;
__device__ __forceinline__ void gate_item(const float* Wsrc, const float* gain, bf16_t* WG, int r, int upsel, LAS float* scr, int lane) {
    const int kb = r / 88, nb = r % 88, n = 32 * nb;
    tr_item(Wsrc, DFF, 64 * kb, n, gain, WG, D, 256 * (n >> 7) + (n & 127) + 128 * upsel, scr, lane);
}
__device__ __forceinline__ void wconv_setA(const WPtrs& w, unsigned char* ws, int it, LAS float* scr, int lane) {
    int r = it;
    if (r < IT_GATE) { gate_item(w.g1, w.n1, (bf16_t*)(ws + WS_WG1), r, 0, scr, lane); return; } r -= IT_GATE;
    if (r < IT_GATE) { gate_item(w.u1, w.n1, (bf16_t*)(ws + WS_WG1), r, 1, scr, lane); return; } r -= IT_GATE;
    if (r < IT_DOWN) { const int kb = r >> 5, nb = r & 31; tr_item(w.d1, D, 64 * kb, 32 * nb, nullptr, (bf16_t*)(ws + WS_WD1), DFF, 32 * nb, scr, lane); return; } r -= IT_DOWN;
    if (r < IT_WIN) { const int kb = r / 40, nb = r % 40; const int sc = nb < 24 ? 32 * nb : 1024 + 32 * (nb - 24);
        tr_item(w.win, DIN, 64 * kb, sc, w.nm, (bf16_t*)(ws + WS_WIN), D, 32 * nb, scr, lane); return; } r -= IT_WIN;
    wpq_item(w.win, w.nm, (bf16_t*)(ws + WS_WPQ), r, scr, lane);
}
__device__ __forceinline__ void wconv_setB(const WPtrs& w, unsigned char* ws, int it, LAS float* scr, int lane) {
    int r = it;
    if (r < IT_WOUT) { const int kb = r >> 5, nb = r & 31; tr_item(w.wout, D, 64 * kb, 32 * nb, w.nb, (bf16_t*)(ws + WS_WOUT), D, 32 * nb, scr, lane); return; } r -= IT_WOUT;
    if (r < IT_GATE) { gate_item(w.g2, w.n2, (bf16_t*)(ws + WS_WG2), r, 0, scr, lane); return; } r -= IT_GATE;
    if (r < IT_GATE) { gate_item(w.u2, w.n2, (bf16_t*)(ws + WS_WG2), r, 1, scr, lane); return; } r -= IT_GATE;
    { const int kb = r >> 5, nb = r & 31; tr_item(w.d2, D, 64 * kb, 32 * nb, nullptr, (bf16_t*)(ws + WS_WD2), DFF, 32 * nb, scr, lane); }
}

constexpr int AT_KS = 272, AT_VS = 144, AT_KB = 64 * AT_KS  , AT_STAGE = AT_KB + 128 * AT_VS  , AT_RED = 2 * AT_STAGE, AT_QSP = AT_RED + 2048;
static_assert(AT_QSP + 8 * 8192 <= LDS_MISC, "attention LDS");
__device__ __forceinline__ void attn_unit(LAS unsigned char* lds, const bf16_t* Z, bf16_t* O, const float* sink_l, int b, int qt, int tid) {
    const int lane = tid & 63, h = __builtin_amdgcn_readfirstlane(tid >> 6), g = lane >> 4, lq = lane & 15, kvh = h >> 2;
    int L, row0; if (b < NBP) { L = LP; row0 = b * LP; } else { L = LS; row0 = TP + (b - NBP) * LS; }
    const int t0 = qt * 64, s0 = t0 - 128;
    const float LOG2E = 1.4426950408889634f;
    const float slope2 = exp2f(-(float)(h + 1)) * LOG2E, sink2 = sink_l[h] * LOG2E, sc2 = 0.125f * LOG2E;
    LAS unsigned char* qsp = lds + AT_QSP + h * 8192 + lane * 16;
#pragma unroll
    for (int qi = 0; qi < 4; ++qi) { int t = t0 + 16 * qi + lq; t = t < L ? t : L - 1; const bf16_t* qp = Z + (size_t)(row0 + t) * DZ + h * 64 + 8 * g;
        *(LAS bf16x8*)(qsp + (2 * qi) * 1024) = *(const bf16x8*)qp; *(LAS bf16x8*)(qsp + (2 * qi + 1) * 1024) = *(const bf16x8*)(qp + 32); }
    float mrun[4], lsum[4]; f32x4 Oa[4][4];
#pragma unroll
    for (int qi = 0; qi < 4; ++qi) { mrun[qi] = sink2; lsum[qi] = (g == 0) ? 1.0f : 0.0f;
#pragma unroll
        for (int dt = 0; dt < 4; ++dt) Oa[qi][dt] = (f32x4){0.f, 0.f, 0.f, 0.f}; }
    int jlo = (81 - t0 + 63) >> 6; if (jlo < 0) jlo = 0;
    int jhi = ((L + 128 - t0 + 63) >> 6) - 1; if (jhi > 4) jhi = 4;
    const int nch = 1 + (jhi - jlo + 1);
    const int slot_s = tid & 63, c8a = tid >> 6;
    u32x4 kreg[2], vreg[2];
#define AT_LOAD(ci) do { int sp = ((ci) == 0) ? slot_s : (s0 + 64 * (jlo + (ci) - 1) + slot_s); sp = sp < 0 ? 0 : (sp > L - 1 ? L - 1 : sp); \
        const bf16_t* rp = Z + (size_t)(row0 + sp) * DZ + 512; \
        kreg[0] = *(const u32x4*)(rp + c8a * 8); kreg[1] = *(const u32x4*)(rp + (c8a + 8) * 8); \
        vreg[0] = *(const u32x4*)(rp + 128 + c8a * 8); vreg[1] = *(const u32x4*)(rp + 128 + (c8a + 8) * 8); } while (0)
#define AT_STORE(st) do { LAS unsigned char* kb_ = lds + (st) * AT_STAGE; LAS unsigned char* vb_ = kb_ + AT_KB; \
        *(LAS u32x4*)(kb_ + slot_s * AT_KS + c8a * 16) = kreg[0]; *(LAS u32x4*)(kb_ + slot_s * AT_KS + (c8a + 8) * 16) = kreg[1]; \
        _Pragma("unroll") for (int i_ = 0; i_ < 2; ++i_) { const int dr_ = (c8a + 8 * i_) * 8; \
            _Pragma("unroll") for (int e_ = 0; e_ < 4; ++e_) { const unsigned w_ = vreg[i_][e_]; \
                *(LAS unsigned short*)(vb_ + (dr_ + 2 * e_) * AT_VS + slot_s * 2) = (unsigned short)(w_ & 0xffffu); \
                *(LAS unsigned short*)(vb_ + (dr_ + 2 * e_ + 1) * AT_VS + slot_s * 2) = (unsigned short)(w_ >> 16); } } } while (0)
    AT_LOAD(0); AT_STORE(0);
    __syncthreads();
    for (int it = 0; it < nch; ++it) {
        const bool more = (it + 1 < nch);
        if (more) AT_LOAD(it + 1);
        const LAS unsigned char* kb = lds + (it & 1) * AT_STAGE; const LAS unsigned char* vb = kb + AT_KB;
        const bool is_meta = (it == 0);
        const int sb = s0 + 64 * (jlo + it - 1);
#pragma unroll
        for (int qi = 0; qi < 4; ++qi) {
            __builtin_amdgcn_sched_barrier(0);
            f32x4 S[4];
            const bf16x8 q0f = *(const LAS bf16x8*)(qsp + (2 * qi) * 1024), q1f = *(const LAS bf16x8*)(qsp + (2 * qi + 1) * 1024);
#pragma unroll
            for (int kt = 0; kt < 4; ++kt) {
                const bf16x8 k0 = *(const LAS bf16x8*)(kb + (16 * kt + lq) * AT_KS + (kvh * 64 + 8 * g) * 2);
                const bf16x8 k1 = *(const LAS bf16x8*)(kb + (16 * kt + lq) * AT_KS + (kvh * 64 + 32 + 8 * g) * 2);
                f32x4 z = (f32x4){0.f, 0.f, 0.f, 0.f};
                z = __builtin_amdgcn_mfma_f32_16x16x32_bf16(k0, q0f, z, 0, 0, 0);
                S[kt] = __builtin_amdgcn_mfma_f32_16x16x32_bf16(k1, q1f, z, 0, 0, 0);
            }
            bf16x8 Pb[2];
            {
                const int tq = t0 + 16 * qi + lq;
                float mx = -1e30f;
#pragma unroll
                for (int kt = 0; kt < 4; ++kt)
#pragma unroll
                    for (int jj = 0; jj < 4; ++jj) {
                        const int slot = 16 * kt + 4 * g + jj; float x;
                        if (is_meta) { x = (slot < 16) ? S[kt][jj] * sc2 : -1e30f; }
                        else { const int s = sb + slot; int ad = tq - s; ad = ad < 0 ? -ad : ad; const bool valid = (ad <= 128) && (s >= NMETA) && (s < L);
                            x = valid ? (S[kt][jj] * sc2 - slope2 * (float)ad) : -1e30f; }
                        S[kt][jj] = x; mx = fmaxf(mx, x);
                    }
                mx = xmax32(xmax16(mx));
                const float mnew = fmaxf(mrun[qi], mx), alpha = __builtin_amdgcn_exp2f(mrun[qi] - mnew); mrun[qi] = mnew;
                float ps = 0.f;
#pragma unroll
                for (int kt = 0; kt < 4; ++kt)
#pragma unroll
                    for (int jj = 0; jj < 4; ++jj) { const float p = __builtin_amdgcn_exp2f(S[kt][jj] - mnew); S[kt][jj] = p; ps += p; }
                lsum[qi] = lsum[qi] * alpha + ps;
#pragma unroll
                for (int dt = 0; dt < 4; ++dt) Oa[qi][dt] = Oa[qi][dt] * alpha;
#pragma unroll
                for (int i = 0; i < 2; ++i) {
                    u32x4 w; w.x = cvt_pk_bf16(S[2 * i][0], S[2 * i][1]); w.y = cvt_pk_bf16(S[2 * i][2], S[2 * i][3]);
                    w.z = cvt_pk_bf16(S[2 * i + 1][0], S[2 * i + 1][1]); w.w = cvt_pk_bf16(S[2 * i + 1][2], S[2 * i + 1][3]);
                    Pb[i] = __builtin_bit_cast(bf16x8, w);
                }
            }
            __builtin_amdgcn_sched_barrier(0);
#pragma unroll
            for (int i = 0; i < 2; ++i)
#pragma unroll
                for (int dt = 0; dt < 4; ++dt) {
                    const LAS unsigned char* vp = vb + (kvh * 64 + 16 * dt + lq) * AT_VS + (32 * i + 4 * g) * 2;
                    const s16x4 v0 = *(const LAS s16x4*)vp, v1 = *(const LAS s16x4*)(vp + 32);
                    const bf16x8 vf = (bf16x8){v0[0], v0[1], v0[2], v0[3], v1[0], v1[1], v1[2], v1[3]};
                    Oa[qi][dt] = __builtin_amdgcn_mfma_f32_16x16x32_bf16(vf, Pb[i], Oa[qi][dt], 0, 0, 0);
                }
        }
        if (more) AT_STORE((it + 1) & 1);
        __syncthreads();
    }
#undef AT_LOAD
#undef AT_STORE
    LAS float* red = (LAS float*)(lds + AT_RED);
#pragma unroll
    for (int qi = 0; qi < 4; ++qi) {
        const float l = xsum_q(lsum[qi]);
        const float inv = 1.0f / l; float q = 0.f;
#pragma unroll
        for (int dt = 0; dt < 4; ++dt) { Oa[qi][dt] = Oa[qi][dt] * inv; const f32x4 x = Oa[qi][dt]; q += (x[0] * x[0] + x[1] * x[1]) + (x[2] * x[2] + x[3] * x[3]); }
        q = xsum_q(q);
        if (g == 0) red[h * 64 + 16 * qi + lq] = q;
    }
    __syncthreads();
#pragma unroll
    for (int qi = 0; qi < 4; ++qi) {
        float tot = 0.f;
#pragma unroll
        for (int hh = 0; hh < 8; ++hh) tot += red[hh * 64 + 16 * qi + lq];
        const float rinv = __builtin_amdgcn_rsqf(tot * (1.0f / 512.0f) + EPS);
        const int t = t0 + 16 * qi + lq;
        if (t < L) {
            bf16_t* op = O + (size_t)(row0 + t) * D + h * 64 + 4 * g;
#pragma unroll
            for (int dt = 0; dt < 4; ++dt) { const f32x4 x = Oa[qi][dt] * rinv; u32x2 w; w.x = cvt_pk_bf16(x[0], x[1]); w.y = cvt_pk_bf16(x[2], x[3]); *(u32x2*)(op + 16 * dt) = w; }
        }
    }
}

__device__ __forceinline__ void conv_unit(LAS unsigned char* lds, const bf16_t* Z, bf16_t* O, const float (&w)[31], float bias, const f32x4 lng, const f32x4 lnb, int b, int qt, int tid) {
    LAS float* U = (LAS float*)lds;
    int L, row0; if (b < NBP) { L = LP; row0 = b * LP; } else { L = LS; row0 = TP + (b - NBP) * LS; }
    const int t0 = qt * 64;
    for (int p = tid; p < 94 * 32; p += 512) {
        const int tt = p >> 5, c8 = p & 31, s = t0 - 15 + tt;
        f32x4 o0 = (f32x4){0.f, 0.f, 0.f, 0.f}, o1 = o0;
        if (s >= 0 && s < L) {
            const bf16_t* rp = Z + (size_t)(row0 + s) * DZ + 768 + c8 * 8;
            const u32x4 a = *(const u32x4*)rp, gg = *(const u32x4*)(rp + 256);
#pragma unroll
            for (int e = 0; e < 4; ++e) {
                const float a_lo = bf_lo(a[e]), a_hi = bf_hi(a[e]), g_lo = bf_lo(gg[e]), g_hi = bf_hi(gg[e]);
                const float v_lo = a_lo * __builtin_amdgcn_rcpf(1.0f + __expf(-g_lo)), v_hi = a_hi * __builtin_amdgcn_rcpf(1.0f + __expf(-g_hi));
                if (e < 2) { o0[2 * e] = v_lo; o0[2 * e + 1] = v_hi; } else { o1[2 * (e - 2)] = v_lo; o1[2 * (e - 2) + 1] = v_hi; }
            }
        }
        *(LAS f32x4*)(U + tt * 256 + c8 * 8) = o0; *(LAS f32x4*)(U + tt * 256 + c8 * 8 + 4) = o1;
    }
    __syncthreads();
    const int c = tid & 255, half = tid >> 8;
    float y[32];
#pragma unroll
    for (int grp = 0; grp < 4; ++grp) {
        const int base = 32 * half + 8 * grp; float in[38];
#pragma unroll
        for (int i = 0; i < 38; ++i) in[i] = U[(base + i) * 256 + c];
#pragma unroll
        for (int o = 0; o < 8; ++o) { float a = bias;
#pragma unroll
            for (int j = 0; j < 31; ++j) a += w[j] * in[o + j];
            y[grp * 8 + o] = a; }
    }
    __syncthreads();
#pragma unroll
    for (int i = 0; i < 32; ++i) U[(32 * half + i) * 256 + c] = y[i];
    __syncthreads();
    const int lane = tid & 63, wv = tid >> 6;
    for (int k = 0; k < 8; ++k) {
        const int tl = 8 * wv + k, s = t0 + tl;
        f32x4 v = *(const LAS f32x4*)(U + tl * 256 + 4 * lane);
        const float mu = wave_sum((v[0] + v[1]) + (v[2] + v[3])) * (1.0f / 256.0f);
        v = v - mu;
        const float var = wave_sum((v[0] * v[0] + v[1] * v[1]) + (v[2] * v[2] + v[3] * v[3])) * (1.0f / 256.0f);
        const float rstd = __builtin_amdgcn_rsqf(var + EPS);
        f32x4 yn = v * rstd * lng + lnb;
#pragma unroll
        for (int e = 0; e < 4; ++e) yn[e] = yn[e] * __builtin_amdgcn_rcpf(1.0f + __expf(-yn[e]));
        const float ssq = wave_sum((yn[0] * yn[0] + yn[1] * yn[1]) + (yn[2] * yn[2] + yn[3] * yn[3]));
        const float rinv = __builtin_amdgcn_rsqf(ssq * (1.0f / 256.0f) + EPS);
        if (s < L) { u32x2 wq; wq.x = cvt_pk_bf16(yn[0] * rinv, yn[1] * rinv); wq.y = cvt_pk_bf16(yn[2] * rinv, yn[3] * rinv);
            *(u32x2*)(O + (size_t)(row0 + s) * D + 768 + 4 * lane) = wq; }
    }
    __syncthreads();
}


#define XB_TMO      128
#define XB_XCNT(j)  (256  + 64 * (j))
#define XB_XSUB(j)  (1280 + 64 * (j))
#define XB_XGEN(j)  (2304 + 64 * (j))
#define XB_TOP      3328
#define XB_TOPGEN   3392
#define XB_SPIN_CAP (1u << 20)
__device__ __forceinline__ unsigned xb_ld(unsigned* p)              { return __hip_atomic_load(p, __ATOMIC_RELAXED, __HIP_MEMORY_SCOPE_AGENT); }
__device__ __forceinline__ unsigned xb_add(unsigned* p, unsigned v) { return __hip_atomic_fetch_add(p, v, __ATOMIC_RELAXED, __HIP_MEMORY_SCOPE_AGENT); }
__device__ __forceinline__ unsigned xb_xcc_id() { return (unsigned)__builtin_amdgcn_s_getreg((3 << 11) | 20) & 0xFu; }
#define XB_SPIN(cond, bar) do { unsigned _sp = 0; while (cond) { __builtin_amdgcn_s_sleep(1); \
    if ((++_sp & 255u) == 0u) { if (xb_ld(&(bar)[XB_TMO])) break; if (_sp > XB_SPIN_CAP) { atomicAdd(&(bar)[XB_TMO], 1u); break; } } } } while (0)
__device__ __forceinline__ void xcd_barrier_complete(unsigned* bar, unsigned x, unsigned& nloc, unsigned& nx) {
    const unsigned G = gridDim.x * gridDim.y * gridDim.z;
    unsigned sum, cnt, mine, sp = 0u;
    for (;;) {
        sum = 0u; cnt = 0u; mine = 0u;
#pragma unroll
        for (unsigned j = 0; j < 16; ++j) { const unsigned c = xb_ld(&bar[XB_XCNT(j)]); sum += c; cnt += (c > 0u) ? 1u : 0u; mine = (j == x) ? c : mine; }
        if (sum == G) break;
        __builtin_amdgcn_s_sleep(1);
        if ((++sp & 255u) == 0u) { if (xb_ld(&bar[XB_TMO])) break; if (sp > XB_SPIN_CAP) { atomicAdd(&bar[XB_TMO], 1u); break; } }
    }
    nloc = mine > 0u ? mine : 1u; nx = cnt > 0u ? cnt : 1u;
}
__device__ __forceinline__ void xcd_barrier(unsigned* bar, volatile LAS unsigned* st) {
    asm volatile("s_waitcnt vmcnt(0)" ::: "memory");
    __syncthreads();
    if (threadIdx.x == 0) {
        const unsigned x = xb_xcc_id();
        __builtin_amdgcn_s_waitcnt(0);
        unsigned nloc = st[0], nx = st[1];
        if (nloc == 0u) { xcd_barrier_complete(bar, x, nloc, nx); st[0] = nloc; st[1] = nx; }
        const unsigned old = xb_add(&bar[XB_XSUB(x)], 1u);
        const unsigned gen = old / nloc;
        if (old + 1u == (gen + 1u) * nloc) {
            __builtin_amdgcn_fence(__ATOMIC_RELEASE, "agent");
            asm volatile("s_waitcnt vmcnt(0)" ::: "memory");
            const unsigned og = xb_add(&bar[XB_TOP], 1u);
            const unsigned tg = og / nx;
            if (og + 1u == (tg + 1u) * nx) xb_add(&bar[XB_TOPGEN], 1u);
            else XB_SPIN(xb_ld(&bar[XB_TOPGEN]) == tg, bar);
            __builtin_amdgcn_fence(__ATOMIC_ACQUIRE, "agent");
            xb_add(&bar[XB_XGEN(x)], 1u);
            asm volatile("s_waitcnt vmcnt(0)" ::: "memory");
        } else {
            XB_SPIN(xb_ld(&bar[XB_XGEN(x)]) == gen, bar);
            __builtin_amdgcn_fence(__ATOMIC_ACQUIRE, "agent");
            asm volatile("s_waitcnt vmcnt(0)" ::: "memory");
        }
    }
    __syncthreads();
}

struct Args { const float* in[21]; float* out; unsigned char* ws; };
constexpr int N_ATT_UNITS = NBP * 33 + NBS * 65;
__device__ __forceinline__ void unit_decode(int u, int& b, int& qt) { if (u < NBP * 33) { b = u / 33; qt = u - b * 33; } else { const int r = u - NBP * 33; b = NBP + r / 65; qt = r - (r / 65) * 65; } }

typedef const __attribute__((address_space(4))) Args* ArgsP;
#define PHASE_BEGIN \
    ArgsP ap = ap0; asm volatile("" : "+s"(ap)); \
    int tid = threadIdx.x; asm volatile("" : "+v"(tid)); \
    const int lane = tid & 63, wave = __builtin_amdgcn_readfirstlane(tid >> 6); \
    const int G = gridDim.x, bid = blockIdx.x, gw = bid * NWAVES + wave, NGW = G * NWAVES; \
    unsigned char* ws = ap->ws; unsigned char* dob = (unsigned char*)ap->out; \
    (void)lane; (void)gw; (void)NGW; (void)ws; (void)dob;
#define P_H ((float*)(ws + WS_H))
#define P_HB ((bf16_t*)(dob + DO_HB))
#define P_ACT ((bf16_t*)(ws + WS_ACT))
#define P_Z ((bf16_t*)(ws + WS_Z))
#define P_O ((bf16_t*)(ws + WS_O))
#define P_PQP ((bf16_t*)(ws + WS_PQ))
#define P_PQS ((bf16_t*)(ws + WS_PQ_S))
#define P_SS(i) ((u64*)(ws + WS_SS) + (size_t)(i) * MP)
#define GRID_SYNC() do { ArgsP ap_ = ap0; asm volatile("" : "+s"(ap_)); xcd_barrier((unsigned*)(ap_->ws + WS_BAR), (volatile LAS unsigned*)(lds + LDS_MISC)); } while (0)

__global__ void __launch_bounds__(512, 2) mega_fwd(Args a_unused) {
    extern __shared__ __attribute__((aligned(16))) unsigned char lds_raw[];
    cg::grid_group grid = cg::this_grid();
    LAS unsigned char* lds = (LAS unsigned char*)lds_raw;
    const ArgsP ap0 = (ArgsP)__builtin_amdgcn_kernarg_segment_ptr();
    if (threadIdx.x < 2) ((volatile LAS unsigned*)(lds + LDS_MISC))[threadIdx.x] = 0u;
    if (threadIdx.x == 0) (void)xb_add((unsigned*)(ap0->ws + WS_BAR) + XB_XCNT(xb_xcc_id()), 1u);

    {
        PHASE_BEGIN
        u64* SS = P_SS(0); float* H = P_H; bf16_t* HB = P_HB;
        LAS float* scr = (LAS float*)(lds + wave * 18432);
        { const size_t n4 = (size_t)12 * MP / 2; f32x4* p = (f32x4*)(SS + MP);
          for (size_t i = (size_t)bid * 512 + tid; i < n4; i += (size_t)G * 512) p[i] = (f32x4){0.f, 0.f, 0.f, 0.f};
          if (bid == 0) for (int i = tid; i < 1024; i += 512) ((unsigned*)(ws + WS_GUARD))[i] = 0u; }
        { const float* xp = ap->in[0]; const float* xs = ap->in[1]; const float* meta = ap->in[2];
        for (int row = gw; row < MP; row += NGW) {
            f32x4 v[4]; float s = 0.f;
            if (row < T) {
                int b, sq; const float* xb;
                if (row < TP) { b = row / LP; sq = row - b * LP; xb = xp + (size_t)b * SEQP * D; } else { const int r = row - TP; b = r / LS; sq = r - b * LS; xb = xs + (size_t)b * SEQS * D; }
                const float* src = sq < NMETA ? meta + (size_t)sq * D : xb + (size_t)(sq - NMETA) * D;
#pragma unroll
                for (int j = 0; j < 4; ++j) { v[j] = *(const f32x4*)(src + 256 * j + 4 * lane); s += (v[j][0] * v[j][0] + v[j][1] * v[j][1]) + (v[j][2] * v[j][2] + v[j][3] * v[j][3]); }
            } else {
#pragma unroll
                for (int j = 0; j < 4; ++j) v[j] = (f32x4){0.f, 0.f, 0.f, 0.f};
            }
            s = wave_sum(s);
#pragma unroll
            for (int j = 0; j < 4; ++j) { *(f32x4*)(H + (size_t)row * D + 256 * j + 4 * lane) = v[j];
                u32x2 w; w.x = cvt_pk_bf16(v[j][0], v[j][1]); w.y = cvt_pk_bf16(v[j][2], v[j][3]); *(u32x2*)(HB + (size_t)row * D + 256 * j + 4 * lane) = w; }
            if (lane == 0) SS[row] = ss_fix(s);
        } }
        {
            bf16_t* TABP = (bf16_t*)(dob + DO_TABP); bf16_t* TABS = (bf16_t*)(dob + DO_TABS);
            const int NP_P = MT_P * (KP_P / 8), NP_S = MT_S * (KP_S / 8);
            for (int p = bid * 512 + tid; p < NP_P + NP_S; p += G * 512) {
                int L, t, k0; bf16_t* dst; float nrm, invL;
                if (p < NP_P) { L = LP; t = p / (KP_P / 8); k0 = (p - t * (KP_P / 8)) * 8; dst = TABP + (size_t)t * KP_P + k0; nrm = 0.00275140752f  ; invL = 1.0f / 2064.0f; }
                else { const int q = p - NP_P; L = LS; t = q / (KP_S / 8); k0 = (q - t * (KP_S / 8)) * 8; dst = TABS + (size_t)t * KP_S + k0; nrm = 0.00194931588f  ; invL = 1.0f / 4112.0f; }
                float vv[8];
                if (t >= L || k0 >= 2 * L) {
#pragma unroll
                    for (int i = 0; i < 8; ++i) vv[i] = 0.f;
                } else {
                    const bool is_sin = k0 >= L; const int kk0 = is_sin ? k0 - L : k0;
                    int mm = (int)(((long long)t * kk0) % L);
#pragma unroll
                    for (int i = 0; i < 8; ++i) { const float fr = (float)mm * invL;
                        vv[i] = is_sin ? -__builtin_amdgcn_sinf(fr) * nrm : __builtin_amdgcn_cosf(fr) * nrm;
                        mm += t; if (mm >= L) mm -= L; }
                }
                u32x4 w; w.x = pk2(vv[0], vv[1]); w.y = pk2(vv[2], vv[3]); w.z = pk2(vv[4], vv[5]); w.w = pk2(vv[6], vv[7]);
                *(u32x4*)dst = w;
            }
        }
        { WPtrs w; w.n1 = ap->in[3]; w.g1 = ap->in[4]; w.u1 = ap->in[5]; w.d1 = ap->in[6]; w.nm = ap->in[7]; w.win = ap->in[8];
          w.nb = nullptr; w.wout = nullptr; w.n2 = nullptr; w.g2 = nullptr; w.u2 = nullptr; w.d2 = nullptr;
          for (int it = gw; it < IT_SETA; it += NGW) wconv_setA(w, ws, it, scr, lane); }
    }
    __syncthreads(); grid.sync();

#pragma unroll 1
    for (int l = 0; l < DEPTH; ++l) {
        { PHASE_BEGIN
          pg8::Gemm g{P_HB, (const bf16_t*)(ws + WS_WG1), D, D, D}; pg8::StaticOrder S; S.init(MP, 2 * DFF, G, bid);
          EpiSwiGLU E{P_ACT, P_SS(3 * l)}; pg8::gemm_phase<EpiSwiGLU, true>(lds, g, S, E); }
        GRID_SYNC();
        { PHASE_BEGIN
          pg8::Gemm g{P_ACT, (const bf16_t*)(ws + WS_WD1), DFF, DFF, DFF}; pg8::StaticOrder S; S.init(MP, D, G, bid);
          EpiDown E{P_H, P_HB, P_SS(3 * l + 1), 0.5f}; pg8::gemm_phase<EpiDown, true>(lds, g, S, E); }
        GRID_SYNC();
        { PHASE_BEGIN
          pg8::Gemm g{P_HB, (const bf16_t*)(ws + WS_WIN), D, D, D}; pg8::StaticOrder S; S.init(MP, DZ, G, bid);
          EpiZ E{P_Z, P_SS(3 * l + 1)}; pg8::gemm_phase<EpiZ, true>(lds, g, S, E); }
        __syncthreads();
        { PHASE_BEGIN
          pg8::Gemm g{(const bf16_t*)(ws + WS_WPQ), P_HB, D, D, D}; pg8::StaticOrder S; S.init(512, MP, G, bid);
          EpiPQ E{P_PQP, P_PQS, P_SS(3 * l + 1)}; pg8::gemm_phase<EpiPQ, true>(lds, g, S, E); }
        GRID_SYNC();
#ifndef SKIP_ATT
        { PHASE_BEGIN
          const float* sink_l = ap->in[13] + l * 8; const bf16_t* Z = P_Z; bf16_t* O = P_O;
          for (int u = bid; u < N_ATT_UNITS; u += G) { int b, qt; unit_decode(u, b, qt); attn_unit(lds, Z, O, sink_l, b, qt, tid); }
        }
        __syncthreads();
#endif
#ifndef SKIP_CONV
        { PHASE_BEGIN
          const bf16_t* Z = P_Z; bf16_t* O = P_O;
          const int c = tid & 255; float w[31];
          const float* wdw = ap->in[9] + (size_t)l * 31 * 256;
#pragma unroll
          for (int j = 0; j < 31; ++j) w[j] = wdw[j * 256 + c];
          const float bias = ap->in[10][l * 256 + c];
          const f32x4 lng = *(const f32x4*)(ap->in[11] + l * 256 + 4 * lane), lnb = *(const f32x4*)(ap->in[12] + l * 256 + 4 * lane);
          for (int u = (G - 1 - bid); u < N_ATT_UNITS; u += G) { int b, qt; unit_decode(u, b, qt); conv_unit(lds, Z, O, w, bias, lng, lnb, b, qt, tid); }
        }
        __syncthreads();
#endif
        { PHASE_BEGIN
          LAS float* scr = (LAS float*)(lds + wave * 18432);
          WPtrs w;
          w.nb = ap->in[14] + (size_t)l * D; w.wout = ap->in[15] + (size_t)l * D * D; w.n2 = ap->in[16] + (size_t)l * D;
          w.g2 = ap->in[17] + (size_t)l * D * DFF; w.u2 = ap->in[18] + (size_t)l * D * DFF; w.d2 = ap->in[19] + (size_t)l * D * DFF;
          const int ln = l + 1 < DEPTH ? l + 1 : l;
          w.n1 = ap->in[3] + (size_t)ln * D; w.g1 = ap->in[4] + (size_t)ln * D * DFF; w.u1 = ap->in[5] + (size_t)ln * D * DFF; w.d1 = ap->in[6] + (size_t)ln * D * DFF;
          w.nm = ap->in[7] + (size_t)ln * D; w.win = ap->in[8] + (size_t)ln * D * DIN;
          for (int it = gw; it < IT_SETB; it += NGW) wconv_setB(w, ws, it, scr, lane);
          if (l + 1 < DEPTH) for (int it = gw; it < IT_SETA; it += NGW) wconv_setA(w, ws, it, scr, lane);
        }
        GRID_SYNC();
        { PHASE_BEGIN
          pg8::Gemm g{(const bf16_t*)(dob + DO_TABP), P_PQP, KP_P, LDB_P, KP_P}; pg8::StaticOrder S; S.init(MT_P, NBP * 256, G, bid);
          EpiDFT E{P_O, LP, 0}; pg8::gemm_phase<EpiDFT, false>(lds, g, S, E); }
        __syncthreads();
        { PHASE_BEGIN
          pg8::Gemm g{(const bf16_t*)(dob + DO_TABS), P_PQS, KP_S, LDB_S, KP_S}; pg8::StaticOrder S; S.init(MT_S, NBS * 256, G, (bid + G - 144) % G);
          EpiDFT E{P_O, LS, TP}; pg8::gemm_phase<EpiDFT, false>(lds, g, S, E); }
        GRID_SYNC();
        { PHASE_BEGIN
          pg8::Gemm g{P_O, (const bf16_t*)(ws + WS_WOUT), D, D, D}; pg8::StaticOrder S; S.init(MP, D, G, bid);
          EpiDown E{P_H, P_HB, P_SS(3 * l + 2), 1.0f}; pg8::gemm_phase<EpiDown, true>(lds, g, S, E); }
        GRID_SYNC();
        { PHASE_BEGIN
          pg8::Gemm g{P_HB, (const bf16_t*)(ws + WS_WG2), D, D, D}; pg8::StaticOrder S; S.init(MP, 2 * DFF, G, bid);
          EpiSwiGLU E{P_ACT, P_SS(3 * l + 2)}; pg8::gemm_phase<EpiSwiGLU, true>(lds, g, S, E); }
        GRID_SYNC();
        { PHASE_BEGIN
          pg8::Gemm g{P_ACT, (const bf16_t*)(ws + WS_WD2), DFF, DFF, DFF}; pg8::StaticOrder S; S.init(MP, D, G, bid);
          EpiDown E{P_H, P_HB, P_SS(3 * l + 3), 0.5f}; pg8::gemm_phase<EpiDown, true>(lds, g, S, E); }
        GRID_SYNC();
    }
    {
        PHASE_BEGIN
        const float* fn = ap->in[20]; const float* H = P_H; float* outp = ap->out;
        f32x4 gn[4];
#pragma unroll
        for (int j = 0; j < 4; ++j) gn[j] = *(const f32x4*)(fn + 256 * j + 4 * lane);
        const int NR = NBP * SEQP + NBS * SEQS;
        for (int r = gw; r < NR; r += NGW) {
            int row;
            if (r < NBP * SEQP) { const int b = r / SEQP, s = r - b * SEQP; row = b * LP + NMETA + s; } else { const int q = r - NBP * SEQP, b = q / SEQS, s = q - b * SEQS; row = TP + b * LS + NMETA + s; }
            f32x4 v[4]; float s2 = 0.f;
#pragma unroll
            for (int j = 0; j < 4; ++j) { v[j] = *(const f32x4*)(H + (size_t)row * D + 256 * j + 4 * lane); s2 += (v[j][0] * v[j][0] + v[j][1] * v[j][1]) + (v[j][2] * v[j][2] + v[j][3] * v[j][3]); }
            const float rr = rs1024f(wave_sum(s2));
#pragma unroll
            for (int j = 0; j < 4; ++j) *(f32x4*)(outp + (size_t)r * D + 256 * j + 4 * lane) = v[j] * rr * gn[j];
        }
    }
}

extern "C" void kernel_launch(void* const* d_in, const int* in_sizes, int n_in, void* d_out, int out_size, void* d_ws, size_t ws_size, hipStream_t stream) {
    static int grid = 0;
    if (grid == 0) {
        int dev = 0, cus = 0, per_cu = 0;
        (void)hipGetDevice(&dev);
        (void)hipDeviceGetAttribute(&cus, hipDeviceAttributeMultiprocessorCount, dev);
        (void)hipFuncSetAttribute((const void*)mega_fwd, hipFuncAttributeMaxDynamicSharedMemorySize, LDS_BYTES);
        (void)hipOccupancyMaxActiveBlocksPerMultiprocessor(&per_cu, (const void*)mega_fwd, 512, LDS_BYTES);
        if (per_cu < 1) per_cu = 1;
        grid = cus * 1;
        if (ws_size < WS_END) { fprintf(stderr, "kernel_launch: workspace too small: %zu < %zu\n", ws_size, (size_t)WS_END); }
    }
    (void)hipMemsetAsync((char*)d_ws + WS_BAR, 0, WS_BAR_BYTES, stream);
    Args a{};
    for (int i = 0; i < 21; ++i) a.in[i] = (const float*)d_in[i];
    a.out = (float*)d_out; a.ws = (unsigned char*)d_ws;
    void* args[] = {&a};
    hipError_t e = hipLaunchCooperativeKernel((const void*)mega_fwd, dim3(grid), dim3(512), args, LDS_BYTES, stream);
    if (e != hipSuccess) fprintf(stderr, "cooperative launch failed: %s (grid %d)\n", hipGetErrorString(e), grid);
}
```

```cpp
#include <hip/hip_runtime.h>
#include <hip/hip_cooperative_groups.h>
#include <cstdint>
#include <cstdio>
namespace cg = cooperative_groups;

#define LAS __attribute__((address_space(3)))
typedef unsigned short bf16_t;
typedef short bf16x8 __attribute__((ext_vector_type(8)));
typedef short s16x4 __attribute__((ext_vector_type(4)));
typedef float f32x4 __attribute__((ext_vector_type(4)));
typedef unsigned u32x4 __attribute__((ext_vector_type(4)));
typedef unsigned u32x2 __attribute__((ext_vector_type(2)));

constexpr int D = 1024, DFF = 2816, DEPTH = 4;
constexpr int LP = 2064, LS = 4112, NBP = 16, NBS = 4, NMETA = 16, SEQP = 2048, SEQS = 4096;
constexpr int TP = NBP * LP;
constexpr int TS = NBS * LS;
constexpr int T = TP + TS;
constexpr int MP = 49664;
constexpr int DZ = 1280;
constexpr int DIN = 1536;
constexpr int KP_P = 4224, KP_S = 8320;
constexpr int MT_P = 2304, MT_S = 4352;
constexpr int LDB_P = 2 * LP, LDB_S = 2 * LS;
constexpr float EPS = 1e-6f;

constexpr size_t WS_H = 0;
constexpr size_t WS_ACT = WS_H + (size_t)MP * D * 4;
constexpr size_t WS_Z = WS_ACT;
constexpr size_t WS_O = WS_Z + (size_t)MP * DZ * 2;
constexpr size_t WS_PQ = WS_O + (size_t)MP * D * 2;
constexpr size_t WS_PQ_S = WS_PQ + (size_t)NBP * 256 * LDB_P * 2;
constexpr size_t WS_PQ_END = WS_PQ_S + (size_t)NBS * 256 * LDB_S * 2;
constexpr size_t WS_TAIL = WS_ACT + (size_t)MP * DFF * 2;
static_assert(WS_PQ_END <= WS_TAIL, "PQ overlay");
constexpr size_t WS_GUARD = WS_TAIL;
constexpr size_t WS_SS = WS_GUARD + 4096;
constexpr size_t WS_WG1 = WS_SS + (size_t)13 * MP * 8;
constexpr size_t WS_WD1 = WS_WG1 + (size_t)2 * DFF * D * 2;
constexpr size_t WS_WIN = WS_WD1 + (size_t)D * DFF * 2;
constexpr size_t WS_WPQ = WS_WIN + (size_t)DZ * D * 2;
constexpr size_t WS_WOUT = WS_WPQ + (size_t)512 * D * 2;
constexpr size_t WS_WG2 = WS_WOUT + (size_t)D * D * 2;
constexpr size_t WS_WD2 = WS_WG2 + (size_t)2 * DFF * D * 2;
constexpr size_t WS_END = WS_WD2 + (size_t)D * DFF * 2;
constexpr size_t WS_BAR = (WS_END + 4095) & ~(size_t)4095;
constexpr size_t WS_BAR_BYTES = 16384;
static_assert(WS_BAR + WS_BAR_BYTES <= (size_t)512 * 1024 * 1024, "workspace");
constexpr size_t DO_HB = 0;
constexpr size_t DO_TABP = DO_HB + (size_t)MP * D * 2;
constexpr size_t DO_TABS = DO_TABP + (size_t)MT_P * KP_P * 2;
constexpr size_t DO_END = DO_TABS + (size_t)MT_S * KP_S * 2;
static_assert(DO_END <= (size_t)(NBP * SEQP + NBS * SEQS) * D * 4, "d_out scratch");

constexpr int LDS_MISC = 147456;
constexpr int LDS_BYTES = 147456 + 256;
constexpr int NWAVES = 8;

__device__ __forceinline__ unsigned cvt_pk_bf16(float lo, float hi) { unsigned r; asm volatile("v_cvt_pk_bf16_f32 %0, %1, %2" : "=v"(r) : "v"(lo), "v"(hi)); return r; }
__device__ __forceinline__ unsigned f2bf(float f) { unsigned u = __builtin_bit_cast(unsigned, f); return (u + 0x7fffu + ((u >> 16) & 1u)) >> 16; }
__device__ __forceinline__ unsigned pk2(float lo, float hi) { return f2bf(lo) | (f2bf(hi) << 16); }
__device__ __forceinline__ float bf_lo(unsigned w) { return __builtin_bit_cast(float, w << 16); }
__device__ __forceinline__ float bf_hi(unsigned w) { return __builtin_bit_cast(float, w & 0xffff0000u); }
__device__ __forceinline__ float xsum16(float v) { const unsigned u = __builtin_bit_cast(unsigned, v); auto r = __builtin_amdgcn_permlane16_swap(u, u, false, false); return __builtin_bit_cast(float, (unsigned)r[0]) + __builtin_bit_cast(float, (unsigned)r[1]); }
__device__ __forceinline__ float xsum32(float v) { const unsigned u = __builtin_bit_cast(unsigned, v); auto r = __builtin_amdgcn_permlane32_swap(u, u, false, false); return __builtin_bit_cast(float, (unsigned)r[0]) + __builtin_bit_cast(float, (unsigned)r[1]); }
__device__ __forceinline__ float xmax16(float v) { const unsigned u = __builtin_bit_cast(unsigned, v); auto r = __builtin_amdgcn_permlane16_swap(u, u, false, false); return fmaxf(__builtin_bit_cast(float, (unsigned)r[0]), __builtin_bit_cast(float, (unsigned)r[1])); }
__device__ __forceinline__ float xmax32(float v) { const unsigned u = __builtin_bit_cast(unsigned, v); auto r = __builtin_amdgcn_permlane32_swap(u, u, false, false); return fmaxf(__builtin_bit_cast(float, (unsigned)r[0]), __builtin_bit_cast(float, (unsigned)r[1])); }
__device__ __forceinline__ float xsum_q(float v) { return xsum32(xsum16(v)); }
__device__ __forceinline__ float wave_sum(float v) {
#pragma unroll
    for (int o = 1; o < 16; o <<= 1) v += __shfl_xor(v, o);
    return xsum_q(v);
}
typedef unsigned long long u64;
typedef u64 u64x2 __attribute__((ext_vector_type(2)));
__device__ __forceinline__ float rs1024f(float ss) { return __builtin_amdgcn_rsqf(ss * (1.0f / 1024.0f) + EPS); }
__device__ __forceinline__ float rs1024(u64 ss) { return __builtin_amdgcn_rsqf((float)ss * (1.0f / (16777216.0f * 1024.0f)) + EPS); }
__device__ __forceinline__ u64 ss_fix(float q) { return (u64)(q * 16777216.0f); }
#define LDS_WAIT() asm volatile("s_waitcnt lgkmcnt(0)" ::: "memory")

namespace pg8 {
constexpr int BM = 256, BK = 64, HALF = 128, HTB = HALF * BK * 2, STAGE_BYTES = 8 * HTB, NXCD = 8, WGM = 8;
__host__ __device__ __forceinline__ int lds_byte(int r, int c) { const int st = (r >> 4) * 2 + (c >> 5), rr = r & 15, cc = c & 31, ob = rr * 64 + cc * 2; return st * 1024 + (ob ^ (((ob >> 9) & 1) << 5)); }
__host__ __device__ __forceinline__ void stage_rc(int b, int& R, int& C) { const int st = b / 1024, sb = b % 1024, swz = sb ^ (((sb >> 9) & 1) << 5); R = (st >> 1) * 16 + swz / 64; C = (st & 1) * 32 + (swz % 64) / 2; }
__host__ __device__ __forceinline__ int perm32(int rho) { const int n = rho >> 4, i = rho & 15; return 8 * (i >> 2) + 4 * n + (i & 3); }

struct Unit { int pm, pn; };
struct Gemm { const bf16_t* A; const bf16_t* Bt; int lda, ldb, K; };

struct StaticOrder {
    int nM, nN, nwg, G, c;
    __device__ void init(int M, int N, int G_, int c_) { nM = M / BM; nN = N / BM; nwg = nM * nN; G = G_; c = c_; }
    __device__ bool next(int i, Unit& u) const {
        const long L = (long)i * G + c; if (L >= nwg) return false;
        int wgid = (int)L; { const int q = nwg / NXCD, r = nwg % NXCD, xcd = wgid % NXCD, off = wgid / NXCD; wgid = (xcd < r ? xcd * (q + 1) : r * (q + 1) + (xcd - r) * q) + off; }
        const int nig = WGM * nN, gid = wgid / nig, fm = gid * WGM, gsz = (nM - fm) < WGM ? (nM - fm) : WGM;
        u.pm = fm + ((wgid % nig) % gsz); u.pn = (wgid % nig) / gsz; return true;
    }
};

template <class Epi, bool ALIGN_EPI>
__device__ __forceinline__ void gemm_phase(LAS unsigned char* lds, const Gemm g, const StaticOrder& S, const Epi& E) {
    int tid_ = threadIdx.x; asm volatile("" : "+v"(tid_));
    const int tid = tid_, wid = __builtin_amdgcn_readfirstlane(tid >> 6), lane = tid & 63, wr = wid >> 2, wc = wid & 3, fr = lane & 15, fq = lane >> 4;
    const int nt = g.K / BK;
    unsigned voffA[2], voffB[2];
#pragma unroll
    for (int i = 0; i < 2; ++i) { int R, C; stage_rc(tid * 16 + i * 8192, R, C); const int Rb = Epi::PERM ? ((R & ~31) + perm32(R & 31)) : R;
        voffA[i] = (unsigned)(R * g.lda + C) * 2u; voffB[i] = (unsigned)(Rb * g.ldb + C) * 2u; }
    const size_t kstep = (size_t)(BK * 2);
    const size_t hstepA = (size_t)HALF * g.lda * 2, hstepB = (size_t)HALF * g.ldb * 2;
    const size_t tstepA = 2 * hstepA, tstepB = 2 * hstepB;
    const unsigned ldsw = (unsigned)wid * 1024u;
    const int aoff = lds_byte(wr * 64 + fr, fq * 8), boff = lds_byte(wc * 32 + fr, fq * 8);
#define PG8_SA(b, h) (((b) * 2 + (h)) * HTB)
#define PG8_SB(b, h) ((4 + (b) * 2 + (h)) * HTB)
#define PG8_STAGE(bufoff, gbase, voff) do { _Pragma("unroll") for (int _i = 0; _i < 2; ++_i) \
        __builtin_amdgcn_global_load_lds((const unsigned*)((const char*)(gbase) + (voff)[_i]), (LAS unsigned*)(lds + (bufoff) + ldsw + _i * 8192), 16, 0, 0); } while (0)
#define PG8_LDA(dst, b, h) do { _Pragma("unroll") for (int m = 0; m < 4; ++m) _Pragma("unroll") for (int k = 0; k < 2; ++k) dst[m][k] = *(const LAS bf16x8*)(lds + PG8_SA(b, h) + aoff + m * 2048 + k * 1024); } while (0)
#define PG8_LDB(dst, b, h) do { _Pragma("unroll") for (int n = 0; n < 2; ++n) _Pragma("unroll") for (int k = 0; k < 2; ++k) dst[n][k] = *(const LAS bf16x8*)(lds + PG8_SB(b, h) + boff + n * 2048 + k * 1024); } while (0)
#define PG8_MMA(ai, bj, At, Bt) do { __builtin_amdgcn_s_setprio(1); _Pragma("unroll") for (int m = 0; m < 4; ++m) _Pragma("unroll") for (int n = 0; n < 2; ++n) _Pragma("unroll") for (int k = 0; k < 2; ++k) \
        acc[ai][bj][m][n] = __builtin_amdgcn_mfma_f32_16x16x32_bf16(Bt[n][k], At[m][k], acc[ai][bj][m][n], 0, 0, 0); __builtin_amdgcn_s_setprio(0); } while (0)
#define PG8_WAIT_V(n) asm volatile("s_waitcnt vmcnt(" #n ")" ::: "memory")
#define PG8_WAIT_L(n) asm volatile("s_waitcnt lgkmcnt(" #n ")" ::: "memory")
#define PG8_BAR __builtin_amdgcn_s_barrier()
#define PG8_SCHED __builtin_amdgcn_sched_barrier(0)
    Unit cur, nxt; int ui = 0;
    if (!S.next(0, cur)) return;
    f32x4 acc[2][2][4][2];
#pragma unroll
    for (int a = 0; a < 2; ++a)
#pragma unroll
        for (int b = 0; b < 2; ++b)
#pragma unroll
            for (int m = 0; m < 4; ++m)
#pragma unroll
                for (int n = 0; n < 2; ++n) acc[a][b][m][n] = (f32x4){0.f, 0.f, 0.f, 0.f};
    bf16x8 At[4][2], B0[2][2], B1[2][2];
    const char* cA = (const char*)g.A + (size_t)cur.pm * tstepA; const char* cB = (const char*)g.Bt + (size_t)cur.pn * tstepB;
    PG8_STAGE(PG8_SB(0, 0), cB, voffB); PG8_STAGE(PG8_SB(0, 1), cB + hstepB, voffB); PG8_STAGE(PG8_SA(0, 0), cA, voffA); PG8_STAGE(PG8_SA(0, 1), cA + hstepA, voffA);
    if (wr == 1) PG8_BAR;
    PG8_WAIT_V(2); PG8_BAR;
    PG8_STAGE(PG8_SB(1, 0), cB + kstep, voffB); PG8_STAGE(PG8_SA(1, 0), cA + kstep, voffA); PG8_STAGE(PG8_SB(1, 1), cB + hstepB + kstep, voffB);
    PG8_WAIT_V(6); PG8_BAR;
    for (;;) {
        const bool has_next = S.next(ui + 1, nxt);
        const char* nA = has_next ? (const char*)g.A + (size_t)nxt.pm * tstepA : cA; const char* nB = has_next ? (const char*)g.Bt + (size_t)nxt.pn * tstepB : cB;
        for (int t = 0; t < nt; t += 2) {
            const bool last = (t == nt - 2);
            const char* a1 = cA + (size_t)(t + 1) * kstep;
            const char* a2 = last ? nA : cA + (size_t)(t + 2) * kstep; const char* b2 = last ? nB : cB + (size_t)(t + 2) * kstep;
            const char* a3 = a2 + kstep; const char* b3 = b2 + kstep;
            PG8_LDB(B0, 0, 0); PG8_LDB(B1, 0, 1); PG8_SCHED; PG8_LDA(At, 0, 0); PG8_STAGE(PG8_SA(1, 1), a1 + hstepA, voffA);
            PG8_WAIT_V(8); PG8_WAIT_L(0); PG8_BAR; PG8_MMA(0, 0, At, B0); PG8_MMA(0, 1, At, B1); PG8_BAR; PG8_SCHED;
            PG8_LDA(At, 0, 1); PG8_STAGE(PG8_SB(0, 0), b2, voffB); PG8_STAGE(PG8_SB(0, 1), b2 + hstepB, voffB); PG8_STAGE(PG8_SA(0, 0), a2, voffA);
            PG8_WAIT_V(8); PG8_WAIT_L(0); PG8_BAR; PG8_MMA(1, 0, At, B0); PG8_MMA(1, 1, At, B1); PG8_BAR; PG8_SCHED;
            PG8_LDB(B0, 1, 0); PG8_LDB(B1, 1, 1); PG8_SCHED; PG8_LDA(At, 1, 0); PG8_STAGE(PG8_SA(0, 1), a2 + hstepA, voffA);
            PG8_WAIT_V(8); PG8_WAIT_L(0); PG8_BAR; PG8_MMA(0, 0, At, B0); PG8_MMA(0, 1, At, B1); PG8_BAR; PG8_SCHED;
            PG8_LDA(At, 1, 1); PG8_STAGE(PG8_SB(1, 0), b3, voffB); PG8_STAGE(PG8_SB(1, 1), b3 + hstepB, voffB); PG8_STAGE(PG8_SA(1, 0), a3, voffA);
            PG8_WAIT_V(8); PG8_WAIT_L(0); PG8_BAR; PG8_MMA(1, 0, At, B0); PG8_MMA(1, 1, At, B1); PG8_BAR; PG8_SCHED;
        }
        if constexpr (ALIGN_EPI) { if (wr == 0) PG8_BAR; }
        if constexpr (!Epi::AFTER_DRAIN) { E(acc, cur, wr, wc, fr, fq); }
        if (!has_next) break;
#pragma unroll
        for (int a = 0; a < 2; ++a)
#pragma unroll
            for (int b = 0; b < 2; ++b)
#pragma unroll
                for (int m = 0; m < 4; ++m)
#pragma unroll
                    for (int n = 0; n < 2; ++n) acc[a][b][m][n] = (f32x4){0.f, 0.f, 0.f, 0.f};
        cur = nxt; cA = nA; cB = nB; ++ui;
        if constexpr (ALIGN_EPI) { if (wr == 1) PG8_BAR; }
    }
    PG8_WAIT_V(0);
    if constexpr (!ALIGN_EPI) { if (wr == 0) PG8_BAR; }
    PG8_BAR;
    if constexpr (Epi::AFTER_DRAIN) { E.fused(acc, cur, wr, wc, fr, fq, lds); }
#undef PG8_SA
#undef PG8_SB
#undef PG8_STAGE
#undef PG8_LDA
#undef PG8_LDB
#undef PG8_MMA
#undef PG8_WAIT_V
#undef PG8_WAIT_L
#undef PG8_BAR
#undef PG8_SCHED
}
}

__device__ __forceinline__ float silu_mul(float g, float u) { return g * u * __builtin_amdgcn_rcpf(1.0f + __expf(-g)); }

struct EpiSwiGLU {
    static constexpr bool PERM = true, AFTER_DRAIN = false;
    bf16_t* act; const u64* ss;
    __device__ __forceinline__ void operator()(const f32x4 (&acc)[2][2][4][2], const pg8::Unit& u, int wr, int wc, int fr, int fq) const {
        const int row0 = u.pm * 256 + wr * 64 + fr, col0 = u.pn * 128 + wc * 32 + 8 * fq;
        u64 sv[8];
#pragma unroll
        for (int i = 0; i < 8; ++i) sv[i] = ss[row0 + (i >> 2) * 128 + (i & 3) * 16];
#pragma unroll
        for (int ai = 0; ai < 2; ++ai)
#pragma unroll
            for (int m = 0; m < 4; ++m) {
                const int row = row0 + ai * 128 + m * 16; const float r = rs1024(sv[ai * 4 + m]);
                const f32x4 g0 = acc[ai][0][m][0] * r, g1 = acc[ai][0][m][1] * r, u0 = acc[ai][1][m][0] * r, u1 = acc[ai][1][m][1] * r;
                u32x4 w;
                w.x = cvt_pk_bf16(silu_mul(g0[0], u0[0]), silu_mul(g0[1], u0[1])); w.y = cvt_pk_bf16(silu_mul(g0[2], u0[2]), silu_mul(g0[3], u0[3]));
                w.z = cvt_pk_bf16(silu_mul(g1[0], u1[0]), silu_mul(g1[1], u1[1])); w.w = cvt_pk_bf16(silu_mul(g1[2], u1[2]), silu_mul(g1[3], u1[3]));
                *(u32x4*)(act + (size_t)row * DFF + col0) = w;
            }
    }
};
struct EpiDown {
    static constexpr bool PERM = true, AFTER_DRAIN = false;
    float* H; bf16_t* HB; u64* ssn; float alpha;
    __device__ __forceinline__ void operator()(const f32x4 (&acc)[2][2][4][2], const pg8::Unit& u, int wr, int wc, int fr, int fq) const {
        const int row0 = u.pm * 256 + wr * 64 + fr, col0 = u.pn * 256 + wc * 32 + 8 * fq;
        f32x4 hv[2][4];
#define ED_LOAD(slot, i) do { const float* hp_ = H + (size_t)(row0 + ((i) >> 2) * 128 + ((i) & 3) * 16) * D + col0; \
            hv[slot][0] = *(const f32x4*)(hp_); hv[slot][1] = *(const f32x4*)(hp_ + 4); hv[slot][2] = *(const f32x4*)(hp_ + 128); hv[slot][3] = *(const f32x4*)(hp_ + 132); } while (0)
        ED_LOAD(0, 0); ED_LOAD(1, 1);
#pragma unroll
        for (int i = 0; i < 8; ++i) {
            const int ai = i >> 2, m = i & 3, sl = i & 1;
            const int row = row0 + ai * 128 + m * 16; float* hp = H + (size_t)row * D + col0; bf16_t* bp = HB + (size_t)row * D + col0;
            float q = 0.f;
            f32x4 a0[2], a1[2];
#pragma unroll
            for (int bj = 0; bj < 2; ++bj) {
                a0[bj] = hv[sl][2 * bj] + acc[ai][bj][m][0] * alpha; a1[bj] = hv[sl][2 * bj + 1] + acc[ai][bj][m][1] * alpha;
            }
            if (i + 2 < 8) ED_LOAD(sl, i + 2);
#pragma unroll
            for (int bj = 0; bj < 2; ++bj) {
                *(f32x4*)(hp + bj * 128) = a0[bj]; *(f32x4*)(hp + bj * 128 + 4) = a1[bj];
                q += (a0[bj][0] * a0[bj][0] + a0[bj][1] * a0[bj][1]) + (a0[bj][2] * a0[bj][2] + a0[bj][3] * a0[bj][3]) + (a1[bj][0] * a1[bj][0] + a1[bj][1] * a1[bj][1]) + (a1[bj][2] * a1[bj][2] + a1[bj][3] * a1[bj][3]);
                u32x4 w; w.x = cvt_pk_bf16(a0[bj][0], a0[bj][1]); w.y = cvt_pk_bf16(a0[bj][2], a0[bj][3]); w.z = cvt_pk_bf16(a1[bj][0], a1[bj][1]); w.w = cvt_pk_bf16(a1[bj][2], a1[bj][3]);
                *(u32x4*)(bp + bj * 128) = w;
            }
            q = xsum_q(q);
            if (fq == 0) atomicAdd(ssn + row, ss_fix(q));
        }
#undef ED_LOAD
    }
};
struct EpiZ {
    static constexpr bool PERM = true, AFTER_DRAIN = false;
    bf16_t* Z; const u64* ss;
    __device__ __forceinline__ void operator()(const f32x4 (&acc)[2][2][4][2], const pg8::Unit& u, int wr, int wc, int fr, int fq) const {
        const int row0 = u.pm * 256 + wr * 64 + fr, col0 = u.pn * 256 + wc * 32 + 8 * fq;
        u64 sv[8];
#pragma unroll
        for (int i = 0; i < 8; ++i) sv[i] = ss[row0 + (i >> 2) * 128 + (i & 3) * 16];
#pragma unroll
        for (int ai = 0; ai < 2; ++ai)
#pragma unroll
            for (int m = 0; m < 4; ++m) {
                const int row = row0 + ai * 128 + m * 16; const float r = rs1024(sv[ai * 4 + m]); bf16_t* zp = Z + (size_t)row * DZ + col0;
#pragma unroll
                for (int bj = 0; bj < 2; ++bj) {
                    const f32x4 a0 = acc[ai][bj][m][0] * r, a1 = acc[ai][bj][m][1] * r;
                    u32x4 w; w.x = cvt_pk_bf16(a0[0], a0[1]); w.y = cvt_pk_bf16(a0[2], a0[3]); w.z = cvt_pk_bf16(a1[0], a1[1]); w.w = cvt_pk_bf16(a1[2], a1[3]);
                    *(u32x4*)(zp + bj * 128) = w;
                }
            }
    }
};
struct EpiPQ {
    static constexpr bool PERM = true, AFTER_DRAIN = false;
    bf16_t* PQP; bf16_t* PQS; const u64* ss;
    __device__ __forceinline__ void operator()(const f32x4 (&acc)[2][2][4][2], const pg8::Unit& u, int wr, int wc, int fr, int fq) const {
        const int ch0 = wr * 64 + fr;
        const int tokb = u.pn * 256 + wc * 32 + 8 * fq;
        u64x2 sv[2][4];
#pragma unroll
        for (int bj = 0; bj < 2; ++bj)
#pragma unroll
            for (int j = 0; j < 4; ++j) sv[bj][j] = *(const u64x2*)(ss + tokb + bj * 128 + 2 * j);
#pragma unroll
        for (int bj = 0; bj < 2; ++bj) {
            const int tok = tokb + bj * 128;
            if (tok < T) {
                bf16_t* base; int L2;
                if (tok < TP) { const int b = tok / LP, s = tok - b * LP; base = PQP + (size_t)b * 256 * LDB_P + u.pm * LP + s; L2 = LDB_P; }
                else { const int tt = tok - TP, b = tt / LS, s = tt - b * LS; base = PQS + (size_t)b * 256 * LDB_S + u.pm * LS + s; L2 = LDB_S; }
                f32x4 r0, r1;
#pragma unroll
                for (int j = 0; j < 2; ++j) { r0[2 * j] = rs1024(sv[bj][j][0]); r0[2 * j + 1] = rs1024(sv[bj][j][1]); r1[2 * j] = rs1024(sv[bj][2 + j][0]); r1[2 * j + 1] = rs1024(sv[bj][2 + j][1]); }
#pragma unroll
                for (int ai = 0; ai < 2; ++ai)
#pragma unroll
                    for (int m = 0; m < 4; ++m) {
                        const int c = ch0 + ai * 128 + m * 16;
                        const f32x4 a0 = acc[ai][bj][m][0] * r0, a1 = acc[ai][bj][m][1] * r1;
                        u32x4 w; w.x = cvt_pk_bf16(a0[0], a0[1]); w.y = cvt_pk_bf16(a0[2], a0[3]); w.z = cvt_pk_bf16(a1[0], a1[1]); w.w = cvt_pk_bf16(a1[2], a1[3]);
                        *(u32x4*)(base + (size_t)c * L2) = w;
                    }
            }
        }
    }
};
struct EpiDFT {
    static constexpr bool PERM = true, AFTER_DRAIN = true;
    bf16_t* O; int L, rowoff;
    __device__ __forceinline__ void operator()(const f32x4 (&)[2][2][4][2], const pg8::Unit&, int, int, int, int) const {}
    __device__ __forceinline__ void fused(const f32x4 (&acc)[2][2][4][2], const pg8::Unit& u, int wr, int wc, int fr, int fq, LAS unsigned char* lds) const {
        LAS float* P = (LAS float*)lds;
#pragma unroll
        for (int ai = 0; ai < 2; ++ai)
#pragma unroll
            for (int m = 0; m < 4; ++m) {
                float q = 0.f;
#pragma unroll
                for (int bj = 0; bj < 2; ++bj)
#pragma unroll
                    for (int n = 0; n < 2; ++n) { const f32x4 x = acc[ai][bj][m][n]; q += (x[0] * x[0] + x[1] * x[1]) + (x[2] * x[2] + x[3] * x[3]); }
                q = xsum_q(q);
                if (fq == 0) P[(ai * 128 + wr * 64 + m * 16 + fr) * 4 + wc] = q;
            }
        LDS_WAIT(); __builtin_amdgcn_s_barrier(); asm volatile("" ::: "memory");
#pragma unroll
        for (int ai = 0; ai < 2; ++ai)
#pragma unroll
            for (int m = 0; m < 4; ++m) {
                const int rl = ai * 128 + wr * 64 + m * 16 + fr; const f32x4 pp = *(const LAS f32x4*)(P + rl * 4);
                const float rinv = __builtin_amdgcn_rsqf(((pp[0] + pp[1]) + (pp[2] + pp[3])) * (1.0f / 256.0f) + EPS);
                const int t = u.pm * 256 + rl;
                if (t < L) {
                    bf16_t* op = O + (size_t)(rowoff + u.pn * L + t) * D + 512 + wc * 32 + 8 * fq;
#pragma unroll
                    for (int bj = 0; bj < 2; ++bj) {
                        const f32x4 a0 = acc[ai][bj][m][0] * rinv, a1 = acc[ai][bj][m][1] * rinv;
                        u32x4 w; w.x = cvt_pk_bf16(a0[0], a0[1]); w.y = cvt_pk_bf16(a0[2], a0[3]); w.z = cvt_pk_bf16(a1[0], a1[1]); w.w = cvt_pk_bf16(a1[2], a1[3]);
                        *(u32x4*)(op + bj * 128) = w;
                    }
                }
            }
        LDS_WAIT(); __builtin_amdgcn_s_barrier(); asm volatile("" ::: "memory");
    }
};

__device__ __forceinline__ void tr_item(const float* W, int ldw, int k0, int nc0, const float* gain, bf16_t* WT, int ldo, int drow0, LAS float* scr, int lane) {
#pragma unroll 8
    for (int i = 0; i < 32; ++i) { const int kk = 2 * i + (lane >> 5); const float gsc = gain ? gain[k0 + kk] : 1.0f;
        scr[kk * 33 + (lane & 31)] = W[(size_t)(k0 + kk) * ldw + nc0 + (lane & 31)] * gsc; }
    LDS_WAIT(); asm volatile("" ::: "memory");
    const int c = lane & 7;
#pragma unroll
    for (int j = 0; j < 4; ++j) { const int n = (lane >> 3) + 8 * j; const LAS float* s = scr + (8 * c) * 33 + n;
        u32x4 o; o.x = pk2(s[0 * 33], s[1 * 33]); o.y = pk2(s[2 * 33], s[3 * 33]); o.z = pk2(s[4 * 33], s[5 * 33]); o.w = pk2(s[6 * 33], s[7 * 33]);
        *(u32x4*)(WT + (size_t)(drow0 + n) * ldo + k0 + 8 * c) = o; }
    LDS_WAIT(); asm volatile("" ::: "memory");
}
__device__ __forceinline__ void wpq_item(const float* Win, const float* gain, bf16_t* WPQ, int item, LAS float* scr, int lane) {
    const int kb = item >> 4, G = (item >> 2) & 3, cq = item & 3, k0 = kb * 64;
    LAS float* tab = scr + 64 * 65;
    tab[lane] = __builtin_amdgcn_cosf((float)lane * (1.0f / 64.0f)); tab[64 + lane] = __builtin_amdgcn_sinf((float)lane * (1.0f / 64.0f));
#pragma unroll 8
    for (int i = 0; i < 64; ++i) scr[lane * 65 + i] = Win[(size_t)(k0 + i) * DIN + 768 + 64 * G + lane] * gain[k0 + i];
    LDS_WAIT(); asm volatile("" ::: "memory");
    for (int cc = 0; cc < 16; ++cc) {
        const int cp = 16 * cq + cc; float aP = 0.f, aQ = 0.f; int idx = 0;
#pragma unroll 8
        for (int c = 0; c < 64; ++c) { const float v = scr[c * 65 + lane]; aP += v * tab[idx]; aQ += v * tab[64 + idx]; idx = (idx + cp) & 63; }
        WPQ[(size_t)(64 * G + cp) * D + k0 + lane] = (bf16_t)f2bf(aP);
        WPQ[(size_t)(256 + 64 * G + cp) * D + k0 + lane] = (bf16_t)f2bf(aQ);
    }
    LDS_WAIT(); asm volatile("" ::: "memory");
}
struct WPtrs { const float *n1, *g1, *u1, *d1, *nm, *win, *nb, *wout, *n2, *g2, *u2, *d2; };
constexpr int IT_GATE = 16 * 88, IT_DOWN = 44 * 32, IT_WIN = 16 * 40, IT_WPQ = 256, IT_WOUT = 16 * 32;
constexpr int IT_SETA = 2 * IT_GATE + IT_DOWN + IT_WIN + IT_WPQ;
constexpr int IT_SETB = IT_WOUT + 2 * IT_GATE + IT_DOWN;
__device__ __forceinline__ void gate_item(const float* Wsrc, const float* gain, bf16_t* WG, int r, int upsel, LAS float* scr, int lane) {
    const int kb = r / 88, nb = r % 88, n = 32 * nb;
    tr_item(Wsrc, DFF, 64 * kb, n, gain, WG, D, 256 * (n >> 7) + (n & 127) + 128 * upsel, scr, lane);
}
__device__ __forceinline__ void wconv_setA(const WPtrs& w, unsigned char* ws, int it, LAS float* scr, int lane) {
    int r = it;
    if (r < IT_GATE) { gate_item(w.g1, w.n1, (bf16_t*)(ws + WS_WG1), r, 0, scr, lane); return; } r -= IT_GATE;
    if (r < IT_GATE) { gate_item(w.u1, w.n1, (bf16_t*)(ws + WS_WG1), r, 1, scr, lane); return; } r -= IT_GATE;
    if (r < IT_DOWN) { const int kb = r >> 5, nb = r & 31; tr_item(w.d1, D, 64 * kb, 32 * nb, nullptr, (bf16_t*)(ws + WS_WD1), DFF, 32 * nb, scr, lane); return; } r -= IT_DOWN;
    if (r < IT_WIN) { const int kb = r / 40, nb = r % 40; const int sc = nb < 24 ? 32 * nb : 1024 + 32 * (nb - 24);
        tr_item(w.win, DIN, 64 * kb, sc, w.nm, (bf16_t*)(ws + WS_WIN), D, 32 * nb, scr, lane); return; } r -= IT_WIN;
    wpq_item(w.win, w.nm, (bf16_t*)(ws + WS_WPQ), r, scr, lane);
}
__device__ __forceinline__ void wconv_setB(const WPtrs& w, unsigned char* ws, int it, LAS float* scr, int lane) {
    int r = it;
    if (r < IT_WOUT) { const int kb = r >> 5, nb = r & 31; tr_item(w.wout, D, 64 * kb, 32 * nb, w.nb, (bf16_t*)(ws + WS_WOUT), D, 32 * nb, scr, lane); return; } r -= IT_WOUT;
    if (r < IT_GATE) { gate_item(w.g2, w.n2, (bf16_t*)(ws + WS_WG2), r, 0, scr, lane); return; } r -= IT_GATE;
    if (r < IT_GATE) { gate_item(w.u2, w.n2, (bf16_t*)(ws + WS_WG2), r, 1, scr, lane); return; } r -= IT_GATE;
    { const int kb = r >> 5, nb = r & 31; tr_item(w.d2, D, 64 * kb, 32 * nb, nullptr, (bf16_t*)(ws + WS_WD2), DFF, 32 * nb, scr, lane); }
}

constexpr int AT_KS = 272, AT_VS = 144, AT_KB = 64 * AT_KS  , AT_STAGE = AT_KB + 128 * AT_VS  , AT_RED = 2 * AT_STAGE, AT_QSP = AT_RED + 2048;
static_assert(AT_QSP + 8 * 8192 <= LDS_MISC, "attention LDS");
__device__ __forceinline__ void attn_unit(LAS unsigned char* lds, const bf16_t* Z, bf16_t* O, const float* sink_l, int b, int qt, int tid) {
    const int lane = tid & 63, h = __builtin_amdgcn_readfirstlane(tid >> 6), g = lane >> 4, lq = lane & 15, kvh = h >> 2;
    int L, row0; if (b < NBP) { L = LP; row0 = b * LP; } else { L = LS; row0 = TP + (b - NBP) * LS; }
    const int t0 = qt * 64, s0 = t0 - 128;
    const float LOG2E = 1.4426950408889634f;
    const float slope2 = exp2f(-(float)(h + 1)) * LOG2E, sink2 = sink_l[h] * LOG2E, sc2 = 0.125f * LOG2E;
    LAS unsigned char* qsp = lds + AT_QSP + h * 8192 + lane * 16;
#pragma unroll
    for (int qi = 0; qi < 4; ++qi) { int t = t0 + 16 * qi + lq; t = t < L ? t : L - 1; const bf16_t* qp = Z + (size_t)(row0 + t) * DZ + h * 64 + 8 * g;
        *(LAS bf16x8*)(qsp + (2 * qi) * 1024) = *(const bf16x8*)qp; *(LAS bf16x8*)(qsp + (2 * qi + 1) * 1024) = *(const bf16x8*)(qp + 32); }
    float mrun[4], lsum[4]; f32x4 Oa[4][4];
#pragma unroll
    for (int qi = 0; qi < 4; ++qi) { mrun[qi] = sink2; lsum[qi] = (g == 0) ? 1.0f : 0.0f;
#pragma unroll
        for (int dt = 0; dt < 4; ++dt) Oa[qi][dt] = (f32x4){0.f, 0.f, 0.f, 0.f}; }
    int jlo = (81 - t0 + 63) >> 6; if (jlo < 0) jlo = 0;
    int jhi = ((L + 128 - t0 + 63) >> 6) - 1; if (jhi > 4) jhi = 4;
    const int nch = 1 + (jhi - jlo + 1);
    const int slot_s = tid & 63, c8a = tid >> 6;
    u32x4 kreg[2], vreg[2];
#define AT_LOAD(ci) do { int sp = ((ci) == 0) ? slot_s : (s0 + 64 * (jlo + (ci) - 1) + slot_s); sp = sp < 0 ? 0 : (sp > L - 1 ? L - 1 : sp); \
        const bf16_t* rp = Z + (size_t)(row0 + sp) * DZ + 512; \
        kreg[0] = *(const u32x4*)(rp + c8a * 8); kreg[1] = *(const u32x4*)(rp + (c8a + 8) * 8); \
        vreg[0] = *(const u32x4*)(rp + 128 + c8a * 8); vreg[1] = *(const u32x4*)(rp + 128 + (c8a + 8) * 8); } while (0)
#define AT_STORE(st) do { LAS unsigned char* kb_ = lds + (st) * AT_STAGE; LAS unsigned char* vb_ = kb_ + AT_KB; \
        *(LAS u32x4*)(kb_ + slot_s * AT_KS + c8a * 16) = kreg[0]; *(LAS u32x4*)(kb_ + slot_s * AT_KS + (c8a + 8) * 16) = kreg[1]; \
        _Pragma("unroll") for (int i_ = 0; i_ < 2; ++i_) { const int dr_ = (c8a + 8 * i_) * 8; \
            _Pragma("unroll") for (int e_ = 0; e_ < 4; ++e_) { const unsigned w_ = vreg[i_][e_]; \
                *(LAS unsigned short*)(vb_ + (dr_ + 2 * e_) * AT_VS + slot_s * 2) = (unsigned short)(w_ & 0xffffu); \
                *(LAS unsigned short*)(vb_ + (dr_ + 2 * e_ + 1) * AT_VS + slot_s * 2) = (unsigned short)(w_ >> 16); } } } while (0)
    AT_LOAD(0); AT_STORE(0);
    __syncthreads();
    for (int it = 0; it < nch; ++it) {
        const bool more = (it + 1 < nch);
        if (more) AT_LOAD(it + 1);
        const LAS unsigned char* kb = lds + (it & 1) * AT_STAGE; const LAS unsigned char* vb = kb + AT_KB;
        const bool is_meta = (it == 0);
        const int sb = s0 + 64 * (jlo + it - 1);
#pragma unroll
        for (int qi = 0; qi < 4; ++qi) {
            __builtin_amdgcn_sched_barrier(0);
            f32x4 S[4];
            const bf16x8 q0f = *(const LAS bf16x8*)(qsp + (2 * qi) * 1024), q1f = *(const LAS bf16x8*)(qsp + (2 * qi + 1) * 1024);
#pragma unroll
            for (int kt = 0; kt < 4; ++kt) {
                const bf16x8 k0 = *(const LAS bf16x8*)(kb + (16 * kt + lq) * AT_KS + (kvh * 64 + 8 * g) * 2);
                const bf16x8 k1 = *(const LAS bf16x8*)(kb + (16 * kt + lq) * AT_KS + (kvh * 64 + 32 + 8 * g) * 2);
                f32x4 z = (f32x4){0.f, 0.f, 0.f, 0.f};
                z = __builtin_amdgcn_mfma_f32_16x16x32_bf16(k0, q0f, z, 0, 0, 0);
                S[kt] = __builtin_amdgcn_mfma_f32_16x16x32_bf16(k1, q1f, z, 0, 0, 0);
            }
            bf16x8 Pb[2];
            {
                const int tq = t0 + 16 * qi + lq;
                float mx = -1e30f;
#pragma unroll
                for (int kt = 0; kt < 4; ++kt)
#pragma unroll
                    for (int jj = 0; jj < 4; ++jj) {
                        const int slot = 16 * kt + 4 * g + jj; float x;
                        if (is_meta) { x = (slot < 16) ? S[kt][jj] * sc2 : -1e30f; }
                        else { const int s = sb + slot; int ad = tq - s; ad = ad < 0 ? -ad : ad; const bool valid = (ad <= 128) && (s >= NMETA) && (s < L);
                            x = valid ? (S[kt][jj] * sc2 - slope2 * (float)ad) : -1e30f; }
                        S[kt][jj] = x; mx = fmaxf(mx, x);
                    }
                mx = xmax32(xmax16(mx));
                const float mnew = fmaxf(mrun[qi], mx), alpha = __builtin_amdgcn_exp2f(mrun[qi] - mnew); mrun[qi] = mnew;
                float ps = 0.f;
#pragma unroll
                for (int kt = 0; kt < 4; ++kt)
#pragma unroll
                    for (int jj = 0; jj < 4; ++jj) { const float p = __builtin_amdgcn_exp2f(S[kt][jj] - mnew); S[kt][jj] = p; ps += p; }
                lsum[qi] = lsum[qi] * alpha + ps;
#pragma unroll
                for (int dt = 0; dt < 4; ++dt) Oa[qi][dt] = Oa[qi][dt] * alpha;
#pragma unroll
                for (int i = 0; i < 2; ++i) {
                    u32x4 w; w.x = cvt_pk_bf16(S[2 * i][0], S[2 * i][1]); w.y = cvt_pk_bf16(S[2 * i][2], S[2 * i][3]);
                    w.z = cvt_pk_bf16(S[2 * i + 1][0], S[2 * i + 1][1]); w.w = cvt_pk_bf16(S[2 * i + 1][2], S[2 * i + 1][3]);
                    Pb[i] = __builtin_bit_cast(bf16x8, w);
                }
            }
            __builtin_amdgcn_sched_barrier(0);
#pragma unroll
            for (int i = 0; i < 2; ++i)
#pragma unroll
                for (int dt = 0; dt < 4; ++dt) {
                    const LAS unsigned char* vp = vb + (kvh * 64 + 16 * dt + lq) * AT_VS + (32 * i + 4 * g) * 2;
                    const s16x4 v0 = *(const LAS s16x4*)vp, v1 = *(const LAS s16x4*)(vp + 32);
                    const bf16x8 vf = (bf16x8){v0[0], v0[1], v0[2], v0[3], v1[0], v1[1], v1[2], v1[3]};
                    Oa[qi][dt] = __builtin_amdgcn_mfma_f32_16x16x32_bf16(vf, Pb[i], Oa[qi][dt], 0, 0, 0);
                }
        }
        if (more) AT_STORE((it + 1) & 1);
        __syncthreads();
    }
#undef AT_LOAD
#undef AT_STORE
    LAS float* red = (LAS float*)(lds + AT_RED);
#pragma unroll
    for (int qi = 0; qi < 4; ++qi) {
        const float l = xsum_q(lsum[qi]);
        const float inv = 1.0f / l; float q = 0.f;
#pragma unroll
        for (int dt = 0; dt < 4; ++dt) { Oa[qi][dt] = Oa[qi][dt] * inv; const f32x4 x = Oa[qi][dt]; q += (x[0] * x[0] + x[1] * x[1]) + (x[2] * x[2] + x[3] * x[3]); }
        q = xsum_q(q);
        if (g == 0) red[h * 64 + 16 * qi + lq] = q;
    }
    __syncthreads();
#pragma unroll
    for (int qi = 0; qi < 4; ++qi) {
        float tot = 0.f;
#pragma unroll
        for (int hh = 0; hh < 8; ++hh) tot += red[hh * 64 + 16 * qi + lq];
        const float rinv = __builtin_amdgcn_rsqf(tot * (1.0f / 512.0f) + EPS);
        const int t = t0 + 16 * qi + lq;
        if (t < L) {
            bf16_t* op = O + (size_t)(row0 + t) * D + h * 64 + 4 * g;
#pragma unroll
            for (int dt = 0; dt < 4; ++dt) { const f32x4 x = Oa[qi][dt] * rinv; u32x2 w; w.x = cvt_pk_bf16(x[0], x[1]); w.y = cvt_pk_bf16(x[2], x[3]); *(u32x2*)(op + 16 * dt) = w; }
        }
    }
}

__device__ __forceinline__ void conv_unit(LAS unsigned char* lds, const bf16_t* Z, bf16_t* O, const float (&w)[31], float bias, const f32x4 lng, const f32x4 lnb, int b, int qt, int tid) {
    LAS float* U = (LAS float*)lds;
    int L, row0; if (b < NBP) { L = LP; row0 = b * LP; } else { L = LS; row0 = TP + (b - NBP) * LS; }
    const int t0 = qt * 64;
    for (int p = tid; p < 94 * 32; p += 512) {
        const int tt = p >> 5, c8 = p & 31, s = t0 - 15 + tt;
        f32x4 o0 = (f32x4){0.f, 0.f, 0.f, 0.f}, o1 = o0;
        if (s >= 0 && s < L) {
            const bf16_t* rp = Z + (size_t)(row0 + s) * DZ + 768 + c8 * 8;
            const u32x4 a = *(const u32x4*)rp, gg = *(const u32x4*)(rp + 256);
#pragma unroll
            for (int e = 0; e < 4; ++e) {
                const float a_lo = bf_lo(a[e]), a_hi = bf_hi(a[e]), g_lo = bf_lo(gg[e]), g_hi = bf_hi(gg[e]);
                const float v_lo = a_lo * __builtin_amdgcn_rcpf(1.0f + __expf(-g_lo)), v_hi = a_hi * __builtin_amdgcn_rcpf(1.0f + __expf(-g_hi));
                if (e < 2) { o0[2 * e] = v_lo; o0[2 * e + 1] = v_hi; } else { o1[2 * (e - 2)] = v_lo; o1[2 * (e - 2) + 1] = v_hi; }
            }
        }
        *(LAS f32x4*)(U + tt * 256 + c8 * 8) = o0; *(LAS f32x4*)(U + tt * 256 + c8 * 8 + 4) = o1;
    }
    __syncthreads();
    const int c = tid & 255, half = tid >> 8;
    float y[32];
#pragma unroll
    for (int grp = 0; grp < 4; ++grp) {
        const int base = 32 * half + 8 * grp; float in[38];
#pragma unroll
        for (int i = 0; i < 38; ++i) in[i] = U[(base + i) * 256 + c];
#pragma unroll
        for (int o = 0; o < 8; ++o) { float a = bias;
#pragma unroll
            for (int j = 0; j < 31; ++j) a += w[j] * in[o + j];
            y[grp * 8 + o] = a; }
    }
    __syncthreads();
#pragma unroll
    for (int i = 0; i < 32; ++i) U[(32 * half + i) * 256 + c] = y[i];
    __syncthreads();
    const int lane = tid & 63, wv = tid >> 6;
    for (int k = 0; k < 8; ++k) {
        const int tl = 8 * wv + k, s = t0 + tl;
        f32x4 v = *(const LAS f32x4*)(U + tl * 256 + 4 * lane);
        const float mu = wave_sum((v[0] + v[1]) + (v[2] + v[3])) * (1.0f / 256.0f);
        v = v - mu;
        const float var = wave_sum((v[0] * v[0] + v[1] * v[1]) + (v[2] * v[2] + v[3] * v[3])) * (1.0f / 256.0f);
        const float rstd = __builtin_amdgcn_rsqf(var + EPS);
        f32x4 yn = v * rstd * lng + lnb;
#pragma unroll
        for (int e = 0; e < 4; ++e) yn[e] = yn[e] * __builtin_amdgcn_rcpf(1.0f + __expf(-yn[e]));
        const float ssq = wave_sum((yn[0] * yn[0] + yn[1] * yn[1]) + (yn[2] * yn[2] + yn[3] * yn[3]));
        const float rinv = __builtin_amdgcn_rsqf(ssq * (1.0f / 256.0f) + EPS);
        if (s < L) { u32x2 wq; wq.x = cvt_pk_bf16(yn[0] * rinv, yn[1] * rinv); wq.y = cvt_pk_bf16(yn[2] * rinv, yn[3] * rinv);
            *(u32x2*)(O + (size_t)(row0 + s) * D + 768 + 4 * lane) = wq; }
    }
    __syncthreads();
}


#define XB_TMO      128
#define XB_XCNT(j)  (256  + 64 * (j))
#define XB_XSUB(j)  (1280 + 64 * (j))
#define XB_XGEN(j)  (2304 + 64 * (j))
#define XB_TOP      3328
#define XB_TOPGEN   3392
#define XB_SPIN_CAP (1u << 20)
#define WQ_WORD(k) (3584 + 64 * (k))
__device__ __forceinline__ unsigned xb_ld(unsigned* p)              { return __hip_atomic_load(p, __ATOMIC_RELAXED, __HIP_MEMORY_SCOPE_AGENT); }
__device__ __forceinline__ unsigned xb_add(unsigned* p, unsigned v) { return __hip_atomic_fetch_add(p, v, __ATOMIC_RELAXED, __HIP_MEMORY_SCOPE_AGENT); }
__device__ __forceinline__ unsigned xb_xcc_id() { return (unsigned)__builtin_amdgcn_s_getreg((3 << 11) | 20) & 0xFu; }
#define XB_SPIN(cond, bar) do { unsigned _sp = 0; while (cond) { __builtin_amdgcn_s_sleep(1); \
    if ((++_sp & 255u) == 0u) { if (xb_ld(&(bar)[XB_TMO])) break; if (_sp > XB_SPIN_CAP) { atomicAdd(&(bar)[XB_TMO], 1u); break; } } } } while (0)
__device__ __forceinline__ void xcd_barrier_complete(unsigned* bar, unsigned x, unsigned& nloc, unsigned& nx) {
    const unsigned G = gridDim.x * gridDim.y * gridDim.z;
    unsigned sum, cnt, mine, sp = 0u;
    for (;;) {
        sum = 0u; cnt = 0u; mine = 0u;
#pragma unroll
        for (unsigned j = 0; j < 16; ++j) { const unsigned c = xb_ld(&bar[XB_XCNT(j)]); sum += c; cnt += (c > 0u) ? 1u : 0u; mine = (j == x) ? c : mine; }
        if (sum == G) break;
        __builtin_amdgcn_s_sleep(1);
        if ((++sp & 255u) == 0u) { if (xb_ld(&bar[XB_TMO])) break; if (sp > XB_SPIN_CAP) { atomicAdd(&bar[XB_TMO], 1u); break; } }
    }
    nloc = mine > 0u ? mine : 1u; nx = cnt > 0u ? cnt : 1u;
}
__device__ __forceinline__ void xcd_barrier(unsigned* bar, volatile LAS unsigned* st) {
    asm volatile("s_waitcnt vmcnt(0)" ::: "memory");
    __syncthreads();
    if (threadIdx.x == 0) {
        const unsigned x = xb_xcc_id();
        __builtin_amdgcn_s_waitcnt(0);
        unsigned nloc = st[0], nx = st[1];
        if (nloc == 0u) { xcd_barrier_complete(bar, x, nloc, nx); st[0] = nloc; st[1] = nx; }
        const unsigned old = xb_add(&bar[XB_XSUB(x)], 1u);
        const unsigned gen = old / nloc;
        if (old + 1u == (gen + 1u) * nloc) {
            __builtin_amdgcn_fence(__ATOMIC_RELEASE, "agent");
            asm volatile("s_waitcnt vmcnt(0)" ::: "memory");
            const unsigned og = xb_add(&bar[XB_TOP], 1u);
            const unsigned tg = og / nx;
            if (og + 1u == (tg + 1u) * nx) xb_add(&bar[XB_TOPGEN], 1u);
            else XB_SPIN(xb_ld(&bar[XB_TOPGEN]) == tg, bar);
            __builtin_amdgcn_fence(__ATOMIC_ACQUIRE, "agent");
            xb_add(&bar[XB_XGEN(x)], 1u);
            asm volatile("s_waitcnt vmcnt(0)" ::: "memory");
        } else {
            XB_SPIN(xb_ld(&bar[XB_XGEN(x)]) == gen, bar);
            __builtin_amdgcn_fence(__ATOMIC_ACQUIRE, "agent");
            asm volatile("s_waitcnt vmcnt(0)" ::: "memory");
        }
    }
    __syncthreads();
}

struct Args { const float* in[21]; float* out; unsigned char* ws; };
constexpr int N_ATT_UNITS = NBP * 33 + NBS * 65;
__device__ __forceinline__ void unit_decode(int u, int& b, int& qt) { if (u < NBP * 33) { b = u / 33; qt = u - b * 33; } else { const int r = u - NBP * 33; b = NBP + r / 65; qt = r - (r / 65) * 65; } }

typedef const __attribute__((address_space(4))) Args* ArgsP;
#define PHASE_BEGIN \
    ArgsP ap = ap0; asm volatile("" : "+s"(ap)); \
    int tid = threadIdx.x; asm volatile("" : "+v"(tid)); \
    const int lane = tid & 63, wave = __builtin_amdgcn_readfirstlane(tid >> 6); \
    const int G = gridDim.x, bid = blockIdx.x, gw = bid * NWAVES + wave, NGW = G * NWAVES; \
    unsigned char* ws = ap->ws; unsigned char* dob = (unsigned char*)ap->out; \
    (void)lane; (void)gw; (void)NGW; (void)ws; (void)dob;
#define P_H ((float*)(ws + WS_H))
#define P_HB ((bf16_t*)(dob + DO_HB))
#define P_ACT ((bf16_t*)(ws + WS_ACT))
#define P_Z ((bf16_t*)(ws + WS_Z))
#define P_O ((bf16_t*)(ws + WS_O))
#define P_PQP ((bf16_t*)(ws + WS_PQ))
#define P_PQS ((bf16_t*)(ws + WS_PQ_S))
#define P_SS(i) ((u64*)(ws + WS_SS) + (size_t)(i) * MP)
#define GRID_SYNC() do { ArgsP ap_ = ap0; asm volatile("" : "+s"(ap_)); xcd_barrier((unsigned*)(ap_->ws + WS_BAR), (volatile LAS unsigned*)(lds + LDS_MISC)); } while (0)

__global__ void __launch_bounds__(512, 2) mega_fwd(Args a_unused) {
    extern __shared__ __attribute__((aligned(16))) unsigned char lds_raw[];
    cg::grid_group grid = cg::this_grid();
    LAS unsigned char* lds = (LAS unsigned char*)lds_raw;
    const ArgsP ap0 = (ArgsP)__builtin_amdgcn_kernarg_segment_ptr();
    if (threadIdx.x < 2) ((volatile LAS unsigned*)(lds + LDS_MISC))[threadIdx.x] = 0u;
    if (threadIdx.x == 0) (void)xb_add((unsigned*)(ap0->ws + WS_BAR) + XB_XCNT(xb_xcc_id()), 1u);

    {
        PHASE_BEGIN
        u64* SS = P_SS(0); float* H = P_H; bf16_t* HB = P_HB;
        LAS float* scr = (LAS float*)(lds + wave * 18432);
        { const size_t n4 = (size_t)12 * MP / 2; f32x4* p = (f32x4*)(SS + MP);
          for (size_t i = (size_t)bid * 512 + tid; i < n4; i += (size_t)G * 512) p[i] = (f32x4){0.f, 0.f, 0.f, 0.f};
          if (bid == 0) for (int i = tid; i < 1024; i += 512) ((unsigned*)(ws + WS_GUARD))[i] = 0u; }
        { const float* xp = ap->in[0]; const float* xs = ap->in[1]; const float* meta = ap->in[2];
        for (int row = gw; row < MP; row += NGW) {
            f32x4 v[4]; float s = 0.f;
            if (row < T) {
                int b, sq; const float* xb;
                if (row < TP) { b = row / LP; sq = row - b * LP; xb = xp + (size_t)b * SEQP * D; } else { const int r = row - TP; b = r / LS; sq = r - b * LS; xb = xs + (size_t)b * SEQS * D; }
                const float* src = sq < NMETA ? meta + (size_t)sq * D : xb + (size_t)(sq - NMETA) * D;
#pragma unroll
                for (int j = 0; j < 4; ++j) { v[j] = *(const f32x4*)(src + 256 * j + 4 * lane); s += (v[j][0] * v[j][0] + v[j][1] * v[j][1]) + (v[j][2] * v[j][2] + v[j][3] * v[j][3]); }
            } else {
#pragma unroll
                for (int j = 0; j < 4; ++j) v[j] = (f32x4){0.f, 0.f, 0.f, 0.f};
            }
            s = wave_sum(s);
#pragma unroll
            for (int j = 0; j < 4; ++j) { *(f32x4*)(H + (size_t)row * D + 256 * j + 4 * lane) = v[j];
                u32x2 w; w.x = cvt_pk_bf16(v[j][0], v[j][1]); w.y = cvt_pk_bf16(v[j][2], v[j][3]); *(u32x2*)(HB + (size_t)row * D + 256 * j + 4 * lane) = w; }
            if (lane == 0) SS[row] = ss_fix(s);
        } }
        {
            bf16_t* TABP = (bf16_t*)(dob + DO_TABP); bf16_t* TABS = (bf16_t*)(dob + DO_TABS);
            const int NP_P = MT_P * (KP_P / 8), NP_S = MT_S * (KP_S / 8);
            for (int p = bid * 512 + tid; p < NP_P + NP_S; p += G * 512) {
                int L, t, k0; bf16_t* dst; float nrm, invL;
                if (p < NP_P) { L = LP; t = p / (KP_P / 8); k0 = (p - t * (KP_P / 8)) * 8; dst = TABP + (size_t)t * KP_P + k0; nrm = 0.00275140752f  ; invL = 1.0f / 2064.0f; }
                else { const int q = p - NP_P; L = LS; t = q / (KP_S / 8); k0 = (q - t * (KP_S / 8)) * 8; dst = TABS + (size_t)t * KP_S + k0; nrm = 0.00194931588f  ; invL = 1.0f / 4112.0f; }
                float vv[8];
                if (t >= L || k0 >= 2 * L) {
#pragma unroll
                    for (int i = 0; i < 8; ++i) vv[i] = 0.f;
                } else {
                    const bool is_sin = k0 >= L; const int kk0 = is_sin ? k0 - L : k0;
                    int mm = (int)(((long long)t * kk0) % L);
#pragma unroll
                    for (int i = 0; i < 8; ++i) { const float fr = (float)mm * invL;
                        vv[i] = is_sin ? -__builtin_amdgcn_sinf(fr) * nrm : __builtin_amdgcn_cosf(fr) * nrm;
                        mm += t; if (mm >= L) mm -= L; }
                }
                u32x4 w; w.x = pk2(vv[0], vv[1]); w.y = pk2(vv[2], vv[3]); w.z = pk2(vv[4], vv[5]); w.w = pk2(vv[6], vv[7]);
                *(u32x4*)dst = w;
            }
        }
        { WPtrs w; w.n1 = ap->in[3]; w.g1 = ap->in[4]; w.u1 = ap->in[5]; w.d1 = ap->in[6]; w.nm = ap->in[7]; w.win = ap->in[8];
          w.nb = nullptr; w.wout = nullptr; w.n2 = nullptr; w.g2 = nullptr; w.u2 = nullptr; w.d2 = nullptr;
          for (int it = gw; it < IT_SETA; it += NGW) wconv_setA(w, ws, it, scr, lane); }
    }
    __syncthreads(); grid.sync();

#pragma unroll 1
    for (int l = 0; l < DEPTH; ++l) {
        { PHASE_BEGIN
          pg8::Gemm g{P_HB, (const bf16_t*)(ws + WS_WG1), D, D, D}; pg8::StaticOrder S; S.init(MP, 2 * DFF, G, bid);
          EpiSwiGLU E{P_ACT, P_SS(3 * l)}; pg8::gemm_phase<EpiSwiGLU, true>(lds, g, S, E); }
        GRID_SYNC();
        { PHASE_BEGIN
          pg8::Gemm g{P_ACT, (const bf16_t*)(ws + WS_WD1), DFF, DFF, DFF}; pg8::StaticOrder S; S.init(MP, D, G, bid);
          EpiDown E{P_H, P_HB, P_SS(3 * l + 1), 0.5f}; pg8::gemm_phase<EpiDown, true>(lds, g, S, E); }
        GRID_SYNC();
        { PHASE_BEGIN
          pg8::Gemm g{P_HB, (const bf16_t*)(ws + WS_WIN), D, D, D}; pg8::StaticOrder S; S.init(MP, DZ, G, bid);
          EpiZ E{P_Z, P_SS(3 * l + 1)}; pg8::gemm_phase<EpiZ, true>(lds, g, S, E); }
        __syncthreads();
        { PHASE_BEGIN
          pg8::Gemm g{(const bf16_t*)(ws + WS_WPQ), P_HB, D, D, D}; pg8::StaticOrder S; S.init(512, MP, G, bid);
          EpiPQ E{P_PQP, P_PQS, P_SS(3 * l + 1)}; pg8::gemm_phase<EpiPQ, true>(lds, g, S, E); }
        GRID_SYNC();
        { PHASE_BEGIN
          pg8::Gemm g{(const bf16_t*)(dob + DO_TABS), P_PQS, KP_S, LDB_S, KP_S}; pg8::StaticOrder S; S.init(MT_S, NBS * 256, G, bid);
          EpiDFT E{P_O, LS, TP}; pg8::gemm_phase<EpiDFT, false>(lds, g, S, E); }
        __syncthreads();
        { PHASE_BEGIN
          pg8::Gemm g{(const bf16_t*)(dob + DO_TABP), P_PQP, KP_P, LDB_P, KP_P}; pg8::StaticOrder S; S.init(MT_P, NBP * 256, G, (bid + G - 68) % G);
          EpiDFT E{P_O, LP, 0}; pg8::gemm_phase<EpiDFT, false>(lds, g, S, E); }
        __syncthreads();
#ifndef SKIP_ATT
        { PHASE_BEGIN
          const float* sink_l = ap->in[13] + l * 8; const bf16_t* Z = P_Z; bf16_t* O = P_O;
          unsigned* cnt = (unsigned*)(ws + WS_BAR) + WQ_WORD(2 * l);
          volatile LAS unsigned* qw = (volatile LAS unsigned*)(lds + LDS_MISC + 16);
          for (;;) {
              __syncthreads();
              if (tid == 0) qw[0] = xb_add(cnt, 1u);
              __syncthreads();
              const int u = (int)qw[0];
              if (u >= N_ATT_UNITS) break;
              int b, qt; unit_decode(N_ATT_UNITS - 1 - u, b, qt); attn_unit(lds, Z, O, sink_l, b, qt, tid);
          }
        }
        __syncthreads();
#endif
#ifndef SKIP_CONV
        { PHASE_BEGIN
          const bf16_t* Z = P_Z; bf16_t* O = P_O;
          const int c = tid & 255; float w[31];
          const float* wdw = ap->in[9] + (size_t)l * 31 * 256;
#pragma unroll
          for (int j = 0; j < 31; ++j) w[j] = wdw[j * 256 + c];
          const float bias = ap->in[10][l * 256 + c];
          const f32x4 lng = *(const f32x4*)(ap->in[11] + l * 256 + 4 * lane), lnb = *(const f32x4*)(ap->in[12] + l * 256 + 4 * lane);
          unsigned* cnt = (unsigned*)(ws + WS_BAR) + WQ_WORD(2 * l + 1);
          volatile LAS unsigned* qw = (volatile LAS unsigned*)(lds + LDS_MISC + 16);
          for (;;) {
              __syncthreads();
              if (tid == 0) qw[0] = xb_add(cnt, 1u);
              __syncthreads();
              const int u = (int)qw[0];
              if (u >= N_ATT_UNITS) break;
              int b, qt; unit_decode(u, b, qt); conv_unit(lds, Z, O, w, bias, lng, lnb, b, qt, tid);
          }
        }
        __syncthreads();
#endif
        { PHASE_BEGIN
          LAS float* scr = (LAS float*)(lds + wave * 18432);
          WPtrs w;
          w.nb = ap->in[14] + (size_t)l * D; w.wout = ap->in[15] + (size_t)l * D * D; w.n2 = ap->in[16] + (size_t)l * D;
          w.g2 = ap->in[17] + (size_t)l * D * DFF; w.u2 = ap->in[18] + (size_t)l * D * DFF; w.d2 = ap->in[19] + (size_t)l * D * DFF;
          const int ln = l + 1 < DEPTH ? l + 1 : l;
          w.n1 = ap->in[3] + (size_t)ln * D; w.g1 = ap->in[4] + (size_t)ln * D * DFF; w.u1 = ap->in[5] + (size_t)ln * D * DFF; w.d1 = ap->in[6] + (size_t)ln * D * DFF;
          w.nm = ap->in[7] + (size_t)ln * D; w.win = ap->in[8] + (size_t)ln * D * DIN;
          for (int it = gw; it < IT_SETB; it += NGW) wconv_setB(w, ws, it, scr, lane);
          if (l + 1 < DEPTH) for (int it = gw; it < IT_SETA; it += NGW) wconv_setA(w, ws, it, scr, lane);
        }
        GRID_SYNC();
        { PHASE_BEGIN
          pg8::Gemm g{P_O, (const bf16_t*)(ws + WS_WOUT), D, D, D}; pg8::StaticOrder S; S.init(MP, D, G, bid);
          EpiDown E{P_H, P_HB, P_SS(3 * l + 2), 1.0f}; pg8::gemm_phase<EpiDown, true>(lds, g, S, E); }
        GRID_SYNC();
        { PHASE_BEGIN
          pg8::Gemm g{P_HB, (const bf16_t*)(ws + WS_WG2), D, D, D}; pg8::StaticOrder S; S.init(MP, 2 * DFF, G, bid);
          EpiSwiGLU E{P_ACT, P_SS(3 * l + 2)}; pg8::gemm_phase<EpiSwiGLU, true>(lds, g, S, E); }
        GRID_SYNC();
        { PHASE_BEGIN
          pg8::Gemm g{P_ACT, (const bf16_t*)(ws + WS_WD2), DFF, DFF, DFF}; pg8::StaticOrder S; S.init(MP, D, G, bid);
          EpiDown E{P_H, P_HB, P_SS(3 * l + 3), 0.5f}; pg8::gemm_phase<EpiDown, true>(lds, g, S, E); }
        GRID_SYNC();
    }
    {
        PHASE_BEGIN
        const float* fn = ap->in[20]; const float* H = P_H; float* outp = ap->out;
        f32x4 gn[4];
#pragma unroll
        for (int j = 0; j < 4; ++j) gn[j] = *(const f32x4*)(fn + 256 * j + 4 * lane);
        const int NR = NBP * SEQP + NBS * SEQS;
        for (int r = gw; r < NR; r += NGW) {
            int row;
            if (r < NBP * SEQP) { const int b = r / SEQP, s = r - b * SEQP; row = b * LP + NMETA + s; } else { const int q = r - NBP * SEQP, b = q / SEQS, s = q - b * SEQS; row = TP + b * LS + NMETA + s; }
            f32x4 v[4]; float s2 = 0.f;
#pragma unroll
            for (int j = 0; j < 4; ++j) { v[j] = *(const f32x4*)(H + (size_t)row * D + 256 * j + 4 * lane); s2 += (v[j][0] * v[j][0] + v[j][1] * v[j][1]) + (v[j][2] * v[j][2] + v[j][3] * v[j][3]); }
            const float rr = rs1024f(wave_sum(s2));
#pragma unroll
            for (int j = 0; j < 4; ++j) *(f32x4*)(outp + (size_t)r * D + 256 * j + 4 * lane) = v[j] * rr * gn[j];
        }
    }
}

extern "C" void kernel_launch(void* const* d_in, const int* in_sizes, int n_in, void* d_out, int out_size, void* d_ws, size_t ws_size, hipStream_t stream) {
    static int grid = 0;
    if (grid == 0) {
        int dev = 0, cus = 0, per_cu = 0;
        (void)hipGetDevice(&dev);
        (void)hipDeviceGetAttribute(&cus, hipDeviceAttributeMultiprocessorCount, dev);
        (void)hipFuncSetAttribute((const void*)mega_fwd, hipFuncAttributeMaxDynamicSharedMemorySize, LDS_BYTES);
        (void)hipOccupancyMaxActiveBlocksPerMultiprocessor(&per_cu, (const void*)mega_fwd, 512, LDS_BYTES);
        if (per_cu < 1) per_cu = 1;
        grid = cus * 1;
        if (ws_size < WS_END) { fprintf(stderr, "kernel_launch: workspace too small: %zu < %zu\n", ws_size, (size_t)WS_END); }
    }
    (void)hipMemsetAsync((char*)d_ws + WS_BAR, 0, WS_BAR_BYTES, stream);
    Args a{};
    for (int i = 0; i < 21; ++i) a.in[i] = (const float*)d_in[i];
    a.out = (float*)d_out; a.ws = (unsigned char*)d_ws;
    void* args[] = {&a};
    hipError_t e = hipLaunchCooperativeKernel((const void*)mega_fwd, dim3(grid), dim3(512), args, LDS_BYTES, stream);
    if (e != hipSuccess) fprintf(stderr, "cooperative launch failed: %s (grid %d)\n", hipGetErrorString(e), grid);
}
```
